# Optimizing an MI355X kernel written in HIP

```python
import jax, jax.numpy as jnp
from jax import lax
import numpy as np

D_MODEL = 1024
BATCH = 4
SEQ = 4096
DEPTH = 1

MEM_LEN = 256
MIX_WIDTH = D_MODEL
SGU_WIDTH = MIX_WIDTH // 2
SGU_GROUPS = 4
SGU_GROUP_DIM = SGU_WIDTH // SGU_GROUPS
CHUNK = 128
SB_WIDTH = MIX_WIDTH - SGU_WIDTH
SB_HEAD_DIM = 64
SB_HEADS = SB_WIDTH // SB_HEAD_DIM
Q_BLOCK = 128
XA_HEADS = 4
XA_HEAD_DIM = D_MODEL // XA_HEADS
D_FF = ((8 * D_MODEL // 3 + 127) // 128) * 128
IN_COLS = 2 * SGU_WIDTH + 3 * SB_WIDTH
EPS = 1e-6

kernel_name = "hybrid_sgu_stickbreaking_macaron_block"


def rmsnorm(x, g):
    xf = x.astype(jnp.float32)
    y = xf * lax.rsqrt(jnp.mean(xf * xf, axis=-1, keepdims=True) + EPS)
    return (y * g.astype(jnp.float32)).astype(x.dtype)


def swiglu(x, w_gate, w_up, w_down):
    return (jax.nn.silu(x @ w_gate) * (x @ w_up)) @ w_down


def chunked_sgu(u, v, norm_g, norm_b, w_s, b_s):
    B, S, G, Dg = v.shape
    vf = v.astype(jnp.float32)
    mu = jnp.mean(vf, axis=-1, keepdims=True)
    var = jnp.mean((vf - mu) ** 2, axis=-1, keepdims=True)
    vn = ((vf - mu) * lax.rsqrt(var + EPS) * norm_g.astype(jnp.float32)
          + norm_b.astype(jnp.float32)).astype(v.dtype)
    vc = vn.reshape(B, S // CHUNK, CHUNK, G, Dg)
    causal = jnp.tril(jnp.ones((CHUNK, CHUNK), dtype=bool))
    w = jnp.where(causal[None], w_s, jnp.zeros_like(w_s)).astype(v.dtype)
    mixed = jnp.einsum('gts,bcsgd->bctgd', w, vc) + b_s.T.astype(v.dtype)[None, None, :, :, None]
    return u * mixed.reshape(B, S, G, Dg)


def stick_breaking_attention(q, k, v):
    B, H, S, Dh = q.shape
    scale = Dh ** -0.5
    outs = []
    for blk in range(S // Q_BLOCK):
        t0 = blk * Q_BLOCK
        t1 = t0 + Q_BLOCK
        qb = q[:, :, t0:t1]
        kb = k[:, :, :t1]
        vb = v[:, :, :t1]
        z = jnp.einsum('bhtd,bhsd->bhts', qb, kb,
                       preferred_element_type=jnp.float32) * scale
        t_idx = t0 + jnp.arange(Q_BLOCK)[:, None]
        s_idx = jnp.arange(t1)[None, :]
        strict = s_idx < t_idx
        log_beta = jax.nn.log_sigmoid(z)
        log_1m = jnp.where(strict, jax.nn.log_sigmoid(-z), 0.0)
        suffix = lax.cumsum(log_1m, axis=log_1m.ndim - 1, reverse=True) - log_1m
        a = jnp.where(strict, jnp.exp(log_beta + suffix), 0.0)
        outs.append(jnp.einsum('bhts,bhsd->bhtd', a.astype(v.dtype), vb))
    return jnp.concatenate(outs, axis=2)


def memory_cross_attention(x, memn, w_q, w_kv, w_o):
    B, S, D = x.shape
    M = memn.shape[1]
    q = (x @ w_q).reshape(B, S, XA_HEADS, XA_HEAD_DIM)
    kv = (memn @ w_kv).reshape(B, M, 2, XA_HEADS, XA_HEAD_DIM)
    k, v = kv[:, :, 0], kv[:, :, 1]
    logits = jnp.einsum('bshd,bmhd->bhsm', q, k,
                        preferred_element_type=jnp.float32) * (XA_HEAD_DIM ** -0.5)
    p = jax.nn.softmax(logits, axis=-1).astype(v.dtype)
    o = jnp.einsum('bhsm,bmhd->bshd', p, v).reshape(B, S, XA_HEADS * XA_HEAD_DIM)
    return o @ w_o


def setup_inputs(seed: int = 0) -> dict:
    key = jax.random.key(seed)
    ks = iter(jax.random.split(key, 40))
    L, D, F = DEPTH, D_MODEL, D_FF

    def nrm(shape, scale):
        return jax.random.normal(next(ks), shape, jnp.float32) * scale

    def gain(shape):
        return 1.0 + nrm(shape, 0.02)

    return {
        "x": nrm((BATCH, SEQ, D), 1.0),
        "mem": nrm((BATCH, MEM_LEN, D), 1.0),
        "ffn1_pre_g": gain((L, D)),
        "ffn1_post_g": gain((L, D)),
        "ffn1_w_gate": nrm((L, D, F), D ** -0.5),
        "ffn1_w_up": nrm((L, D, F), D ** -0.5),
        "ffn1_w_down": nrm((L, F, D), F ** -0.5),
        "mix_pre_g": gain((L, D)),
        "mix_post_g": gain((L, D)),
        "w_in": nrm((L, D, IN_COLS), D ** -0.5),
        "sgu_norm_g": gain((L, SGU_GROUPS, SGU_GROUP_DIM)),
        "sgu_norm_b": nrm((L, SGU_GROUPS, SGU_GROUP_DIM), 0.02),
        "sgu_w_s": nrm((L, SGU_GROUPS, CHUNK, CHUNK), CHUNK ** -0.5),
        "sgu_b_s": 1.0 + nrm((L, SGU_GROUPS, CHUNK), 0.02),
        "sgu_out_g": gain((L, SGU_WIDTH)),
        "sb_out_g": gain((L, SB_WIDTH)),
        "w_out": nrm((L, MIX_WIDTH, D), MIX_WIDTH ** -0.5),
        "xa_pre_g": gain((L, D)),
        "xa_post_g": gain((L, D)),
        "mem_norm_g": gain((L, D)),
        "xa_w_q": nrm((L, D, XA_HEADS * XA_HEAD_DIM), D ** -0.5),
        "xa_w_kv": nrm((L, D, 2 * XA_HEADS * XA_HEAD_DIM), D ** -0.5),
        "xa_w_o": nrm((L, XA_HEADS * XA_HEAD_DIM, D), (XA_HEADS * XA_HEAD_DIM) ** -0.5),
        "ffn2_pre_g": gain((L, D)),
        "ffn2_post_g": gain((L, D)),
        "ffn2_w_gate": nrm((L, D, F), D ** -0.5),
        "ffn2_w_up": nrm((L, D, F), D ** -0.5),
        "ffn2_w_down": nrm((L, F, D), F ** -0.5),
        "final_norm_g": gain((L, D)),
    }


def reference(x, mem, ffn1_pre_g, ffn1_post_g, ffn1_w_gate, ffn1_w_up, ffn1_w_down,
              mix_pre_g, mix_post_g, w_in, sgu_norm_g, sgu_norm_b, sgu_w_s, sgu_b_s,
              sgu_out_g, sb_out_g, w_out, xa_pre_g, xa_post_g, mem_norm_g, xa_w_q,
              xa_w_kv, xa_w_o, ffn2_pre_g, ffn2_post_g, ffn2_w_gate, ffn2_w_up,
              ffn2_w_down, final_norm_g):
    B, S, D = x.shape
    splits = [SGU_WIDTH, 2 * SGU_WIDTH, 2 * SGU_WIDTH + SB_WIDTH,
              2 * SGU_WIDTH + 2 * SB_WIDTH]
    h = x
    for l in range(DEPTH):
        f = swiglu(rmsnorm(h, ffn1_pre_g[l]), ffn1_w_gate[l], ffn1_w_up[l], ffn1_w_down[l])
        h = h + 0.5 * rmsnorm(f, ffn1_post_g[l])

        n = rmsnorm(h, mix_pre_g[l])
        proj = n @ w_in[l]
        u, vg, q, k, vs = jnp.split(proj, splits, axis=-1)
        u = jax.nn.gelu(u).reshape(B, S, SGU_GROUPS, SGU_GROUP_DIM)
        vg = jax.nn.gelu(vg).reshape(B, S, SGU_GROUPS, SGU_GROUP_DIM)
        out_a = chunked_sgu(u, vg, sgu_norm_g[l], sgu_norm_b[l],
                            sgu_w_s[l], sgu_b_s[l]).reshape(B, S, SGU_WIDTH)

        def heads(t):
            return t.reshape(B, S, SB_HEADS, SB_HEAD_DIM).transpose(0, 2, 1, 3)
        out_b = stick_breaking_attention(heads(q), heads(k), heads(vs))
        out_b = out_b.transpose(0, 2, 1, 3).reshape(B, S, SB_WIDTH)

        merged = jnp.concatenate([rmsnorm(out_a, sgu_out_g[l]),
                                  rmsnorm(out_b, sb_out_g[l])], axis=-1)
        h = h + rmsnorm(merged @ w_out[l], mix_post_g[l])

        c = memory_cross_attention(rmsnorm(h, xa_pre_g[l]), rmsnorm(mem, mem_norm_g[l]),
                                   xa_w_q[l], xa_w_kv[l], xa_w_o[l])
        h = h + rmsnorm(c, xa_post_g[l])

        f = swiglu(rmsnorm(h, ffn2_pre_g[l]), ffn2_w_gate[l], ffn2_w_up[l], ffn2_w_down[l])
        h = h + 0.5 * rmsnorm(f, ffn2_post_g[l])

        h = rmsnorm(h, final_norm_g[l])
    return h
```

```cpp
#include <hip/hip_runtime.h>
#include <hip/hip_cooperative_groups.h>
#include <cstdio>
#include <cstdint>
namespace cg = cooperative_groups;
namespace pg8 {
#define PG8_LAS __attribute__((address_space(3)))
typedef unsigned short bf16_t;
typedef short bf16x8 __attribute__((ext_vector_type(8)));
typedef float f32x4 __attribute__((ext_vector_type(4)));
typedef unsigned u32x4 __attribute__((ext_vector_type(4)));
constexpr int BM = 256, BK = 64, HALF = 128, HTB = HALF * BK * 2  , STAGE_BYTES = 8 * HTB, NXCD = 8, WGM = 8;

__host__ __device__ __forceinline__ int lds_byte(int r, int c) { const int st = (r >> 4) * 2 + (c >> 5), rr = r & 15, cc = c & 31, ob = rr * 64 + cc * 2; return st * 1024 + (ob ^ (((ob >> 9) & 1) << 5)); }
__host__ __device__ __forceinline__ void stage_rc(int b, int& R, int& C) { const int st = b / 1024, sb = b % 1024, swz = sb ^ (((sb >> 9) & 1) << 5); R = (st >> 1) * 16 + swz / 64; C = (st & 1) * 32 + (swz % 64) / 2; }
__host__ __device__ __forceinline__ int perm32(int rho) { const int n = rho >> 4, i = rho & 15; return 8 * (i >> 2) + 4 * n + (i & 3); }

struct Unit { int pm, pn; };
struct Gemm { const bf16_t* A; const bf16_t* Bt; int M, N, K; };

struct StaticOrder {
    int nM, nN, nwg, G, c;
    __host__ __device__ void init(int M, int N, int G_, int c_) { nM = M / BM; nN = N / BM; nwg = nM * nN; G = G_; c = c_; }
    __host__ __device__ bool next(int i, Unit& u) const {
        const long L = (long)i * G + c; if (L >= nwg) return false;
        int wgid = (int)L; { const int q = nwg / NXCD, r = nwg % NXCD, xcd = wgid % NXCD, off = wgid / NXCD; wgid = (xcd < r ? xcd * (q + 1) : r * (q + 1) + (xcd - r) * q) + off; }
        const int nig = WGM * nN, gid = wgid / nig, fm = gid * WGM, gsz = (nM - fm) < WGM ? (nM - fm) : WGM;
        u.pm = fm + ((wgid % nig) % gsz); u.pn = (wgid % nig) / gsz; return true;
    }
    __device__ __forceinline__ void a_ready(const Unit&) const {}
    __device__ __forceinline__ void done(const Unit&) const {}
};

__device__ __forceinline__ unsigned cvt_pk_bf16(float lo, float hi) { unsigned r; asm volatile("v_cvt_pk_bf16_f32 %0, %1, %2" : "=v"(r) : "v"(lo), "v"(hi)); return r; }
typedef float f32x2 __attribute__((ext_vector_type(2)));
__device__ __forceinline__ float sigmoid_l2(float t) { return __builtin_amdgcn_rcpf(1.0f + __builtin_amdgcn_exp2f(-t)); }
__device__ __forceinline__ float silu_f(float g) { return g * sigmoid_l2(g * 1.4426950408889634f); }
__device__ __forceinline__ float gelu_tanh_f(float x) { const float u = x + 0.044715f * x * x * x; return x * sigmoid_l2(u * (2.0f * 0.7978845608028654f * 1.4426950408889634f)); }

struct EpiF32 {
    static constexpr bool PERM = false, AFTER_DRAIN = false;
    float* C; int ldc;
    __device__ __forceinline__ void operator()(const f32x4 (&acc)[2][2][4][2], const Unit& u, int wr, int wc, int fr, int fq) const {
        const int row0 = u.pm * BM + wr * 64 + fr, col0 = u.pn * BM + wc * 32 + 4 * fq;
#pragma unroll
        for (int ai = 0; ai < 2; ++ai)
#pragma unroll
            for (int m = 0; m < 4; ++m) { float* rowp = C + (size_t)(row0 + ai * HALF + m * 16) * ldc + col0;
#pragma unroll
                for (int bj = 0; bj < 2; ++bj)
#pragma unroll
                    for (int n = 0; n < 2; ++n) *(f32x4*)(rowp + bj * HALF + n * 16) = acc[ai][bj][m][n]; }
    }
};
struct EpiBf16P {
    static constexpr bool PERM = true, AFTER_DRAIN = false;
    bf16_t* O; int ldc; int split_cols; size_t split_stride; int n_gelu;
    __device__ __forceinline__ void operator()(const f32x4 (&acc)[2][2][4][2], const Unit& u, int wr, int wc, int fr, int fq) const {
        const int row0 = u.pm * BM + wr * 64 + fr; int colt = u.pn * BM; bf16_t* base = O; bool act = false;
        if (split_cols) { const int t = colt / split_cols; base += (size_t)t * split_stride; colt -= t * split_cols; act = t < n_gelu; }
        const int col0 = colt + wc * 32 + 8 * fq;
#pragma unroll
        for (int ai = 0; ai < 2; ++ai)
#pragma unroll
            for (int m = 0; m < 4; ++m) { bf16_t* rowp = base + (size_t)(row0 + ai * HALF + m * 16) * ldc + col0;
#pragma unroll
                for (int bj = 0; bj < 2; ++bj) { f32x4 v0 = acc[ai][bj][m][0], v1 = acc[ai][bj][m][1];
                    if (act) {
#pragma unroll
                        for (int j = 0; j < 4; ++j) { v0[j] = gelu_tanh_f(v0[j]); v1[j] = gelu_tanh_f(v1[j]); } }
                    u32x4 w; w.x = cvt_pk_bf16(v0[0], v0[1]); w.y = cvt_pk_bf16(v0[2], v0[3]); w.z = cvt_pk_bf16(v1[0], v1[1]); w.w = cvt_pk_bf16(v1[2], v1[3]);
                    *(u32x4*)(rowp + bj * HALF) = w; } }
    }
};
struct EpiSwiGLU {
    static constexpr bool PERM = true, AFTER_DRAIN = false;
    bf16_t* H; int ldh;
    __device__ __forceinline__ void operator()(const f32x4 (&acc)[2][2][4][2], const Unit& u, int wr, int wc, int fr, int fq) const {
        const int row0 = u.pm * BM + wr * 64 + fr, col0 = u.pn * HALF + wc * 32 + 8 * fq;
#pragma unroll
        for (int ai = 0; ai < 2; ++ai)
#pragma unroll
            for (int m = 0; m < 4; ++m) { bf16_t* rowp = H + (size_t)(row0 + ai * HALF + m * 16) * ldh + col0;
                f32x4 h0, h1;
#pragma unroll
                for (int j = 0; j < 4; ++j) { h0[j] = silu_f(acc[ai][0][m][0][j]) * acc[ai][1][m][0][j]; h1[j] = silu_f(acc[ai][0][m][1][j]) * acc[ai][1][m][1][j]; }
                u32x4 w; w.x = cvt_pk_bf16(h0[0], h0[1]); w.y = cvt_pk_bf16(h0[2], h0[3]); w.z = cvt_pk_bf16(h1[0], h1[1]); w.w = cvt_pk_bf16(h1[2], h1[3]);
                *(u32x4*)rowp = w; }
    }
};
template <class Epi, class Sched, bool ALIGN_EPI = false, bool SP2 = false>
__device__ __forceinline__ void gemm_phase(PG8_LAS unsigned char* lds, const Gemm g, const Sched& S, const Epi& E) {
    const int tid = threadIdx.x, wid = __builtin_amdgcn_readfirstlane(tid >> 6), lane = tid & 63, wr = wid >> 2, wc = wid & 3, fr = lane & 15, fq = lane >> 4;
    const int K = g.K, nt = K / BK;
    unsigned voffA[2], voffB[2];
#pragma unroll
    for (int i = 0; i < 2; ++i) { int R, C; stage_rc(tid * 16 + i * 8192, R, C); const int Rb = Epi::PERM ? ((R & ~31) + perm32(R & 31)) : R;
        voffA[i] = (unsigned)(R * K + C) * 2u; voffB[i] = (unsigned)(Rb * K + C) * 2u; }
    const size_t kstep = (size_t)(BK * 2);
    const size_t hstep = (size_t)HALF * K * 2;
    const size_t tstep = 2 * hstep;
    const unsigned ldsw = (unsigned)wid * 1024u;
    const int aoff = lds_byte(wr * 64 + fr, fq * 8), boff = lds_byte(wc * 32 + fr, fq * 8);
#define PG8_SA(b, h) (((b) * 2 + (h)) * HTB)
#define PG8_SB(b, h) ((4 + (b) * 2 + (h)) * HTB)
#define PG8_STAGE(bufoff, gbase, voff) do { _Pragma("unroll") for (int _i = 0; _i < 2; ++_i) \
        __builtin_amdgcn_global_load_lds((const unsigned*)((const char*)(gbase) + (voff)[_i]), (PG8_LAS unsigned*)(lds + (bufoff) + ldsw + _i * 8192), 16, 0, 0); } while (0)
#define PG8_LDA(dst, b, h) do { _Pragma("unroll") for (int m = 0; m < 4; ++m) _Pragma("unroll") for (int k = 0; k < 2; ++k) dst[m][k] = *(const PG8_LAS bf16x8*)(lds + PG8_SA(b, h) + aoff + m * 2048 + k * 1024); } while (0)
#define PG8_LDB(dst, b, h) do { _Pragma("unroll") for (int n = 0; n < 2; ++n) _Pragma("unroll") for (int k = 0; k < 2; ++k) dst[n][k] = *(const PG8_LAS bf16x8*)(lds + PG8_SB(b, h) + boff + n * 2048 + k * 1024); } while (0)
#define PG8_MMA(ai, bj, At, Bt) do { __builtin_amdgcn_s_setprio(1); _Pragma("unroll") for (int m = 0; m < 4; ++m) _Pragma("unroll") for (int n = 0; n < 2; ++n) _Pragma("unroll") for (int k = 0; k < 2; ++k) \
        acc[ai][bj][m][n] = __builtin_amdgcn_mfma_f32_16x16x32_bf16(Bt[n][k], At[m][k], acc[ai][bj][m][n], 0, 0, 0); __builtin_amdgcn_s_setprio(0); } while (0)
#define PG8_WAIT_V(n) asm volatile("s_waitcnt vmcnt(" #n ")" ::: "memory")
#define PG8_WAIT_L(n) asm volatile("s_waitcnt lgkmcnt(" #n ")" ::: "memory")
#define PG8_BAR __builtin_amdgcn_s_barrier()
#define PG8_SCHED __builtin_amdgcn_sched_barrier(0)
    Unit cur, nxt; int ui = 0;
    if (!S.next(0, cur)) return;
    f32x4 acc[2][2][4][2];
#pragma unroll
    for (int a = 0; a < 2; ++a)
#pragma unroll
        for (int b = 0; b < 2; ++b)
#pragma unroll
            for (int m = 0; m < 4; ++m)
#pragma unroll
                for (int n = 0; n < 2; ++n) acc[a][b][m][n] = (f32x4){0.f, 0.f, 0.f, 0.f};
    bf16x8 At[4][2], B0[2][2], B1[2][2];
    const char* cA = (const char*)g.A + (size_t)cur.pm * tstep; const char* cB = (const char*)g.Bt + (size_t)cur.pn * tstep;
    S.a_ready(cur);
    if constexpr (SP2) {
        PG8_STAGE(PG8_SB(0, 0), cB, voffB); PG8_STAGE(PG8_SB(0, 1), cB + hstep, voffB); PG8_STAGE(PG8_SA(0, 0), cA, voffA); PG8_STAGE(PG8_SA(0, 1), cA + hstep, voffA);
        if (wr == 1) PG8_BAR;
        PG8_WAIT_V(2); PG8_BAR;
        PG8_STAGE(PG8_SB(1, 0), cB + kstep, voffB); PG8_STAGE(PG8_SA(1, 0), cA + kstep, voffA); PG8_STAGE(PG8_SB(1, 1), cB + hstep + kstep, voffB);
        PG8_WAIT_V(6); PG8_BAR;
    } else {
        PG8_STAGE(PG8_SB(0, 0), cB, voffB); PG8_STAGE(PG8_SA(0, 0), cA, voffA); PG8_STAGE(PG8_SB(0, 1), cB + hstep, voffB); PG8_STAGE(PG8_SA(0, 1), cA + hstep, voffA);
        if (wr == 1) PG8_BAR;
        PG8_WAIT_V(4); PG8_BAR;
        PG8_STAGE(PG8_SB(1, 0), cB + kstep, voffB); PG8_STAGE(PG8_SA(1, 0), cA + kstep, voffA); PG8_STAGE(PG8_SB(1, 1), cB + hstep + kstep, voffB);
        PG8_WAIT_V(6); PG8_BAR;
    }
    for (;;) {
        const bool has_next = S.next(ui + 1, nxt);
        const char* nA = has_next ? (const char*)g.A + (size_t)nxt.pm * tstep : cA; const char* nB = has_next ? (const char*)g.Bt + (size_t)nxt.pn * tstep : cB;
        for (int t = 0; t < nt; t += 2) {
            const bool last = (t == nt - 2);
            const char* a1 = cA + (size_t)(t + 1) * kstep;
            const char* a2 = last ? nA : cA + (size_t)(t + 2) * kstep; const char* b2 = last ? nB : cB + (size_t)(t + 2) * kstep;
            const char* a3 = a2 + kstep; const char* b3 = b2 + kstep;
            if (last && has_next) S.a_ready(nxt);
            if constexpr (SP2) {
            PG8_LDB(B0, 0, 0); PG8_LDB(B1, 0, 1); PG8_SCHED; PG8_LDA(At, 0, 0); PG8_STAGE(PG8_SA(1, 1), a1 + hstep, voffA);
            PG8_WAIT_V(8); PG8_WAIT_L(0); PG8_BAR; PG8_MMA(0, 0, At, B0); PG8_MMA(0, 1, At, B1); PG8_BAR; PG8_SCHED;
            PG8_LDA(At, 0, 1); PG8_STAGE(PG8_SB(0, 0), b2, voffB); PG8_STAGE(PG8_SB(0, 1), b2 + hstep, voffB); PG8_STAGE(PG8_SA(0, 0), a2, voffA);
            PG8_WAIT_V(8); PG8_WAIT_L(0); PG8_BAR; PG8_MMA(1, 0, At, B0); PG8_MMA(1, 1, At, B1); PG8_BAR; PG8_SCHED;
            PG8_LDB(B0, 1, 0); PG8_LDB(B1, 1, 1); PG8_SCHED; PG8_LDA(At, 1, 0); PG8_STAGE(PG8_SA(0, 1), a2 + hstep, voffA);
            PG8_WAIT_V(8); PG8_WAIT_L(0); PG8_BAR; PG8_MMA(0, 0, At, B0); PG8_MMA(0, 1, At, B1); PG8_BAR; PG8_SCHED;
            PG8_LDA(At, 1, 1); PG8_STAGE(PG8_SB(1, 0), b3, voffB); PG8_STAGE(PG8_SB(1, 1), b3 + hstep, voffB); PG8_STAGE(PG8_SA(1, 0), a3, voffA);
            PG8_WAIT_V(8); PG8_WAIT_L(0); PG8_BAR; PG8_MMA(1, 0, At, B0); PG8_MMA(1, 1, At, B1); PG8_BAR; PG8_SCHED;
            } else {
            PG8_LDB(B0, 0, 0); PG8_SCHED; PG8_LDA(At, 0, 0); PG8_STAGE(PG8_SA(1, 1), a1 + hstep, voffA);
            PG8_WAIT_L(8); PG8_BAR; PG8_WAIT_L(0); PG8_MMA(0, 0, At, B0); PG8_BAR; PG8_SCHED;
            PG8_LDB(B1, 0, 1); PG8_STAGE(PG8_SB(0, 0), b2, voffB);
            PG8_BAR; PG8_WAIT_L(0); PG8_MMA(0, 1, At, B1); PG8_BAR;
            PG8_LDA(At, 0, 1); PG8_STAGE(PG8_SA(0, 0), a2, voffA);
            PG8_BAR; PG8_WAIT_L(0); PG8_MMA(1, 0, At, B0); PG8_BAR; PG8_SCHED;
            PG8_STAGE(PG8_SB(0, 1), b2 + hstep, voffB);
            PG8_WAIT_V(6); PG8_BAR; PG8_MMA(1, 1, At, B1); PG8_BAR;
            PG8_LDB(B0, 1, 0); PG8_SCHED; PG8_LDA(At, 1, 0); PG8_STAGE(PG8_SA(0, 1), a2 + hstep, voffA);
            PG8_WAIT_L(8); PG8_BAR; PG8_WAIT_L(0); PG8_MMA(0, 0, At, B0); PG8_BAR; PG8_SCHED;
            PG8_LDB(B1, 1, 1); PG8_STAGE(PG8_SB(1, 0), b3, voffB);
            PG8_BAR; PG8_WAIT_L(0); PG8_MMA(0, 1, At, B1); PG8_BAR;
            PG8_LDA(At, 1, 1); PG8_STAGE(PG8_SA(1, 0), a3, voffA);
            PG8_BAR; PG8_WAIT_L(0); PG8_MMA(1, 0, At, B0); PG8_BAR; PG8_SCHED;
            PG8_STAGE(PG8_SB(1, 1), b3 + hstep, voffB);
            PG8_WAIT_V(6); PG8_BAR; PG8_MMA(1, 1, At, B1); PG8_BAR;
            }
        }
        if constexpr (ALIGN_EPI) { if (wr == 0) PG8_BAR; }
        if constexpr (!Epi::AFTER_DRAIN) { E(acc, cur, wr, wc, fr, fq); S.done(cur); }
        if (!has_next) break;
#pragma unroll
        for (int a = 0; a < 2; ++a)
#pragma unroll
            for (int b = 0; b < 2; ++b)
#pragma unroll
                for (int m = 0; m < 4; ++m)
#pragma unroll
                    for (int n = 0; n < 2; ++n) acc[a][b][m][n] = (f32x4){0.f, 0.f, 0.f, 0.f};
        cur = nxt; cA = nA; cB = nB; ++ui;
        if constexpr (ALIGN_EPI) { if (wr == 1) PG8_BAR; }
    }
    PG8_WAIT_V(0);
    if constexpr (!ALIGN_EPI) { if (wr == 0) PG8_BAR; }
    PG8_BAR;
    if constexpr (Epi::AFTER_DRAIN) { E.fused(acc, cur, wr, wc, fr, fq, lds, wid, lane); S.done(cur); }
#undef PG8_SA
#undef PG8_SB
#undef PG8_STAGE
#undef PG8_LDA
#undef PG8_LDB
#undef PG8_MMA
#undef PG8_WAIT_V
#undef PG8_WAIT_L
#undef PG8_BAR
#undef PG8_SCHED
}
}
#ifndef PG8_SP2
#define PG8_SP2 true
#endif
#ifndef PG8_ALIGN
#define PG8_ALIGN true
#endif
#ifndef MK_PER_PHASE
#define MK_PER_PHASE 0
#endif

constexpr int NWAVES = 8;
constexpr int BATCH = 4, SEQ = 4096, D = 1024, FF = 2816, T = BATCH * SEQ, MEMLEN = 256, TM = BATCH * MEMLEN;
constexpr float EPS = 1e-6f;
constexpr float LOG2E = 1.4426950408889634f;
enum { I_X = 0, I_MEM, I_F1PRE, I_F1POST, I_F1WG, I_F1WU, I_F1WD, I_MIXPRE, I_MIXPOST, I_WIN, I_SGU_NG, I_SGU_NB, I_SGU_WS, I_SGU_BS, I_SGU_OG, I_SB_OG, I_WOUT,
       I_XAPRE, I_XAPOST, I_MEMG, I_XAWQ, I_XAWKV, I_XAWO, I_F2PRE, I_F2POST, I_F2WG, I_F2WU, I_F2WD, I_FINAL, N_IN };
constexpr size_t MiB = 1u << 20;
constexpr size_t WS_CTL = 0, CTL_ZERO_BYTES = 16384;
constexpr size_t WS_WGU1 = 2 * MiB, WS_WD1 = 13 * MiB, WS_WIN = 18 * MiB + 512 * 1024, WS_WOUT = 23 * MiB + 512 * 1024, WS_WQ = 25 * MiB + 512 * 1024,
                 WS_WKV = 27 * MiB + 512 * 1024, WS_WO = 31 * MiB + 512 * 1024, WS_WGU2 = 33 * MiB + 512 * 1024, WS_WD2 = 44 * MiB + 512 * 1024;
constexpr size_t WS_MEMN = 50 * MiB, WS_KMEM = 52 * MiB, WS_VMT = 54 * MiB;
constexpr size_t WS_XN = 56 * MiB;
constexpr size_t WS_HB = 88 * MiB;
constexpr size_t WS_U = 88 * MiB, WS_VG = 104 * MiB, WS_Q = 120 * MiB, WS_KK = 136 * MiB, WS_VT = 152 * MiB;
constexpr size_t WS_QX = 88 * MiB, WS_OC = 120 * MiB;
constexpr size_t WS_F = 176 * MiB, WS_END = 240 * MiB;
static_assert(WS_WGU1 + (size_t)2 * FF * D * 2 <= WS_WD1 && WS_WD1 + (size_t)D * FF * 2 <= WS_WIN && WS_WIN + (size_t)2560 * D * 2 <= WS_WOUT && WS_WGU2 + (size_t)2 * FF * D * 2 <= WS_WD2 && WS_WD2 + (size_t)D * FF * 2 <= WS_MEMN, "ws map");
static_assert(WS_HB + (size_t)T * FF * 2 <= WS_F, "ws map");

constexpr int LDS_BYTES = 147456;
constexpr int RING_BYTES = 131072;

#define GAS __attribute__((address_space(1)))
#define LAS __attribute__((address_space(3)))
typedef unsigned short bf16;
typedef unsigned v4u __attribute__((ext_vector_type(4)));
typedef unsigned v2u __attribute__((ext_vector_type(2)));
typedef float f32x4 __attribute__((ext_vector_type(4)));
typedef float f32x16 __attribute__((ext_vector_type(16)));
typedef short bf16x8 __attribute__((ext_vector_type(8)));
typedef short s16x4 __attribute__((ext_vector_type(4)));
typedef __bf16 bf16x2_t __attribute__((ext_vector_type(2)));
typedef float f32x2_t __attribute__((ext_vector_type(2)));
#define LDS_WAIT() asm volatile("s_waitcnt lgkmcnt(0)" ::: "memory")
#define MFMA32(a, b, c) __builtin_amdgcn_mfma_f32_32x32x16_bf16((a), (b), (c), 0, 0, 0)
#define MFMA16(a, b, c) __builtin_amdgcn_mfma_f32_16x16x32_bf16((a), (b), (c), 0, 0, 0)
__device__ __forceinline__ unsigned f2bf(float f) { unsigned u = __builtin_bit_cast(unsigned, f); return (u + 0x7fffu + ((u >> 16) & 1u)) >> 16; }
__device__ __forceinline__ unsigned pk2(float lo, float hi) { return f2bf(lo) | (f2bf(hi) << 16); }
__device__ __forceinline__ unsigned cvtpk(float lo, float hi) { f32x2_t v = {lo, hi}; bf16x2_t b = __builtin_convertvector(v, bf16x2_t); return __builtin_bit_cast(unsigned, b); }
__device__ __forceinline__ float bflo(unsigned w) { return __builtin_bit_cast(float, w << 16); }
__device__ __forceinline__ float bfhi(unsigned w) { return __builtin_bit_cast(float, w & 0xffff0000u); }
__device__ __forceinline__ float wave_sum(float v) {
#pragma unroll
    for (int o = 1; o < 64; o <<= 1) v += __shfl_xor(v, o);
    return v;
}
__device__ __forceinline__ int crow(int r, int hi) { return (r & 3) + 8 * (r >> 2) + 4 * hi; }

__device__ __forceinline__ void transpose_item(const float* W, int K, int N, bf16* WT, int k0, int n0, int dst_row0, LAS float* scr, int lane) {
#pragma unroll 8
    for (int i = 0; i < 32; ++i) { const int kk = 2 * i + (lane >> 5); scr[kk * 33 + (lane & 31)] = W[(size_t)(k0 + kk) * N + n0 + (lane & 31)]; }
    LDS_WAIT(); asm volatile("" ::: "memory");
    const int c = lane & 7;
#pragma unroll
    for (int j = 0; j < 4; ++j) { const int n = (lane >> 3) + 8 * j; const LAS float* s = scr + (8 * c) * 33 + n;
        v4u o; o.x = pk2(s[0 * 33], s[1 * 33]); o.y = pk2(s[2 * 33], s[3 * 33]); o.z = pk2(s[4 * 33], s[5 * 33]); o.w = pk2(s[6 * 33], s[7 * 33]);
        *(v4u*)(WT + (size_t)(dst_row0 + n) * K + k0 + 8 * c) = o; }
    LDS_WAIT(); asm volatile("" ::: "memory");
}
__device__ __forceinline__ void transpose_mat(const float* W, int K, int N, bf16* WT, int mode, int item, LAS float* scr, int lane) {
    const int nblk = N / 32, kb = item / nblk, nb = item % nblk, n0 = 32 * nb;
    const int dst = mode == 0 ? n0 : ((n0 >> 7) * 256 + (n0 & 127) + (mode == 2 ? 128 : 0));
    transpose_item(W, K, N, WT, 64 * kb, n0, dst, scr, lane);
}

struct Row { f32x4 v[4]; };
__device__ __forceinline__ Row row_load(const float* p, int lane) { Row r; const f32x4* q = (const f32x4*)p + lane;
#pragma unroll
    for (int j = 0; j < 4; ++j) r.v[j] = q[64 * j];
    return r; }
__device__ __forceinline__ float row_rstd(const Row& r) { float s = 0.f;
#pragma unroll
    for (int j = 0; j < 4; ++j) s += (r.v[j].x * r.v[j].x + r.v[j].y * r.v[j].y) + (r.v[j].z * r.v[j].z + r.v[j].w * r.v[j].w);
    return 1.0f / sqrtf(wave_sum(s) * (1.0f / D) + EPS); }
__device__ __forceinline__ void row_store_bf16(bf16* orow, const Row& r, float sc, const Row& g, int lane) {
    unsigned long long* o8 = (unsigned long long*)orow + lane;
#pragma unroll
    for (int j = 0; j < 4; ++j) { const f32x4 y = r.v[j] * sc * g.v[j]; o8[64 * j] = (unsigned long long)pk2(y.x, y.y) | ((unsigned long long)pk2(y.z, y.w) << 32); }
}
__device__ __forceinline__ void row_store_f32(float* orow, const Row& r, int lane) { f32x4* q = (f32x4*)orow + lane;
#pragma unroll
    for (int j = 0; j < 4; ++j) q[64 * j] = r.v[j]; }
__device__ __forceinline__ void rows_norm_bf16(const float* x, const float* g, bf16* xn, int nrows, int gw, int ngw, int lane) {
    const Row G = row_load(g, lane);
    for (int m = gw; m < nrows; m += ngw) { const Row r = row_load(x + (size_t)m * D, lane); row_store_bf16(xn + (size_t)m * D, r, row_rstd(r), G, lane); }
}
template <bool FINAL>
__device__ __forceinline__ void rows_resid(const float* hin, const float* f, float w, const float* g1, const float* g2, float* hout, bf16* xn, int gw, int ngw, int lane) {
    const Row G1 = row_load(g1, lane), G2 = row_load(g2, lane);
    for (int m = gw; m < T; m += ngw) {
        const Row fr = row_load(f + (size_t)m * D, lane); Row h = row_load(hin + (size_t)m * D, lane);
        const float sc = row_rstd(fr) * w;
#pragma unroll
        for (int j = 0; j < 4; ++j) h.v[j] = h.v[j] + fr.v[j] * sc * G1.v[j];
        const float s2 = row_rstd(h);
        if (FINAL) { Row o;
#pragma unroll
            for (int j = 0; j < 4; ++j) o.v[j] = h.v[j] * s2 * G2.v[j];
            row_store_f32(hout + (size_t)m * D, o, lane);
        } else { row_store_f32(hout + (size_t)m * D, h, lane); row_store_bf16(xn + (size_t)m * D, h, s2, G2, lane); }
    }
}

#define XB_TMO      128
#define XB_XCNT(j)  (256  + 64 * (j))
#define XB_XSUB(j)  (1280 + 64 * (j))
#define XB_XGEN(j)  (2304 + 64 * (j))
#define XB_TOP      3328
#define XB_TOPGEN   3392
#define XCD_BAR_WORDS 3456
#define XB_SPIN_CAP (1u << 18)

__device__ __forceinline__ unsigned xb_ld(unsigned* p)              { return __hip_atomic_load(p, __ATOMIC_RELAXED, __HIP_MEMORY_SCOPE_AGENT); }
__device__ __forceinline__ unsigned xb_add(unsigned* p, unsigned v) { return __hip_atomic_fetch_add(p, v, __ATOMIC_RELAXED, __HIP_MEMORY_SCOPE_AGENT); }
__device__ __forceinline__ unsigned xb_xcc_id() { return (unsigned)__builtin_amdgcn_s_getreg((3 << 11) | 20) & 0xFu; }
#define XB_SPIN(cond, bar) do { unsigned _sp = 0; while (cond) { __builtin_amdgcn_s_sleep(1); \
    if ((++_sp & 255u) == 0u) { if (xb_ld(&(bar)[XB_TMO])) break; if (_sp > XB_SPIN_CAP) { atomicAdd(&(bar)[XB_TMO], 1u); break; } } } } while (0)

struct XcdBarrier {
    unsigned* bar; unsigned x;
    volatile LAS unsigned* st;
};

__device__ __forceinline__ XcdBarrier xcd_barrier_post(unsigned* bar, volatile LAS unsigned* st) {
    XcdBarrier b; b.bar = bar; b.x = xb_xcc_id(); b.st = st;
    if (threadIdx.x == 0) (void)xb_add(&bar[XB_XCNT(b.x)], 1u);
    return b;
}
__device__ __forceinline__ void xcd_barrier_complete(unsigned* bar, unsigned x, unsigned& nloc, unsigned& nx) {
    const unsigned G = gridDim.x * gridDim.y * gridDim.z;
    unsigned sum, cnt, mine, sp = 0u;
    for (;;) {
        sum = 0u; cnt = 0u; mine = 0u;
#pragma unroll
        for (unsigned j = 0; j < 16; ++j) { const unsigned c = xb_ld(&bar[XB_XCNT(j)]); sum += c; cnt += (c > 0u) ? 1u : 0u; mine = (j == x) ? c : mine; }
        if (sum == G) break;
        __builtin_amdgcn_s_sleep(1);
        if ((++sp & 255u) == 0u) { if (xb_ld(&bar[XB_TMO])) break; if (sp > XB_SPIN_CAP) { atomicAdd(&bar[XB_TMO], 1u); break; } }
    }
    nloc = mine > 0u ? mine : 1u; nx = cnt > 0u ? cnt : 1u;
}

__device__ __forceinline__ void xcd_barrier(const XcdBarrier& b) {
    asm volatile("s_waitcnt vmcnt(0)" ::: "memory");
    __syncthreads();
    if (threadIdx.x == 0) {
        unsigned* bar = b.bar;
        __builtin_amdgcn_s_waitcnt(0);
        unsigned nloc = b.st[0], nx = b.st[1];
        if (nloc == 0u) { xcd_barrier_complete(bar, b.x, nloc, nx); b.st[0] = nloc; b.st[1] = nx; }
        const unsigned old = xb_add(&bar[XB_XSUB(b.x)], 1u);
        const unsigned gen = old / nloc;
        if (old + 1u == (gen + 1u) * nloc) {
            __builtin_amdgcn_fence(__ATOMIC_RELEASE, "agent");
            asm volatile("s_waitcnt vmcnt(0)" ::: "memory");
            const unsigned og = xb_add(&bar[XB_TOP], 1u);
            const unsigned tg = og / nx;
            if (og + 1u == (tg + 1u) * nx) xb_add(&bar[XB_TOPGEN], 1u);
            else XB_SPIN(xb_ld(&bar[XB_TOPGEN]) == tg, bar);
            __builtin_amdgcn_fence(__ATOMIC_ACQUIRE, "agent");
            xb_add(&bar[XB_XGEN(b.x)], 1u);
            asm volatile("s_waitcnt vmcnt(0)" ::: "memory");
        } else {
            XB_SPIN(xb_ld(&bar[XB_XGEN(b.x)]) == gen, bar);
            __builtin_amdgcn_fence(__ATOMIC_ACQUIRE, "agent");
            asm volatile("s_waitcnt vmcnt(0)" ::: "memory");
        }
    }
    __syncthreads();
}
constexpr float SB_THR = -152.0f;
__device__ __forceinline__ void sb_unit(const bf16* Q, const bf16* Kk, const bf16* VT, const float* gb, bf16* merged, LAS float* red, int unit, int wave, int lane) {
    const int b = unit >> 6, q0 = (unit & 63) * 64, h = wave, j = lane & 31, hi = lane >> 5;
    const size_t tb = (size_t)b * SEQ;
    const bf16* Qp = Q + tb * 512 + h * 64;
    const bf16* Kp = Kk + tb * 512 + h * 64;
    const bf16* Vp = VT + (size_t)(h * 64) * T + tb;
    const float CSC = 0.125f * LOG2E;
    bf16x8 qf[2][4];
#pragma unroll
    for (int qg = 0; qg < 2; ++qg)
#pragma unroll
        for (int kk = 0; kk < 4; ++kk) qf[qg][kk] = *(const bf16x8*)(Qp + (size_t)(q0 + 32 * qg + j) * 512 + 16 * kk + 8 * hi);
    f32x16 o[2][2];
#pragma unroll
    for (int a = 0; a < 2; ++a)
#pragma unroll
        for (int c = 0; c < 2; ++c)
#pragma unroll
            for (int r = 0; r < 16; ++r) o[a][c][r] = 0.f;
    float carry[2] = {0.f, 0.f}; bool done[2] = {false, false};
    for (int kt = (q0 >> 5) + 1; kt >= 0; --kt) {
        const int k0 = kt * 32;
        bf16x8 kf[4], vf[2][2];
#pragma unroll
        for (int kk = 0; kk < 4; ++kk) kf[kk] = *(const bf16x8*)(Kp + (size_t)(k0 + j) * 512 + 16 * kk + 8 * hi);
#pragma unroll
        for (int dt = 0; dt < 2; ++dt)
#pragma unroll
            for (int ks = 0; ks < 2; ++ks) { const bf16* vp = Vp + (size_t)(dt * 32 + j) * T + k0 + 16 * ks + 4 * hi;
                const s16x4 lo = *(const s16x4*)vp, h4 = *(const s16x4*)(vp + 8);
                vf[dt][ks] = (bf16x8){lo[0], lo[1], lo[2], lo[3], h4[0], h4[1], h4[2], h4[3]}; }
#pragma unroll
        for (int qg = 0; qg < 2; ++qg) {
            const int qbase = q0 + 32 * qg;
            if (done[qg] || k0 > qbase + 31) continue;
            f32x16 z;
#pragma unroll
            for (int r = 0; r < 16; ++r) z[r] = 0.f;
#pragma unroll
            for (int kk = 0; kk < 4; ++kk) z = MFMA32(kf[kk], qf[qg][kk], z);
            const bool diag = (k0 + 31 >= qbase);
            const int tq = qbase + j;
            float L[16], lb[16];
#pragma unroll
            for (int r = 0; r < 16; ++r) {
                const float zz = z[r] * CSC;
                const float e = __builtin_amdgcn_exp2f(-__builtin_fabsf(zz));
                const float sp = __builtin_fmaxf(zz, 0.f) + __builtin_amdgcn_logf(1.0f + e);
                const bool valid = !diag || (k0 + crow(r, hi) < tq);
                L[r] = valid ? -sp : 0.f;
                lb[r] = valid ? (zz - sp) : -1.0e30f;
            }
            float G[4], Gp[4];
#pragma unroll
            for (int g = 0; g < 4; ++g) { G[g] = (L[4 * g] + L[4 * g + 1]) + (L[4 * g + 2] + L[4 * g + 3]); Gp[g] = __shfl_xor(G[g], 32); }
            float run = carry[qg];
            float a[16];
#pragma unroll
            for (int g = 3; g >= 0; --g) {
                const float s3 = run + (hi == 0 ? Gp[g] : 0.f);
                const float s2 = s3 + L[4 * g + 3], s1 = s2 + L[4 * g + 2], s0 = s1 + L[4 * g + 1];
                a[4 * g + 3] = __builtin_amdgcn_exp2f(lb[4 * g + 3] + s3);
                a[4 * g + 2] = __builtin_amdgcn_exp2f(lb[4 * g + 2] + s2);
                a[4 * g + 1] = __builtin_amdgcn_exp2f(lb[4 * g + 1] + s1);
                a[4 * g + 0] = __builtin_amdgcn_exp2f(lb[4 * g + 0] + s0);
                run += G[g] + Gp[g];
            }
            carry[qg] = run;
#pragma unroll
            for (int ks = 0; ks < 2; ++ks) {
                v4u w; w.x = cvtpk(a[8 * ks], a[8 * ks + 1]); w.y = cvtpk(a[8 * ks + 2], a[8 * ks + 3]); w.z = cvtpk(a[8 * ks + 4], a[8 * ks + 5]); w.w = cvtpk(a[8 * ks + 6], a[8 * ks + 7]);
                const bf16x8 pf = __builtin_bit_cast(bf16x8, w);
#pragma unroll
                for (int dt = 0; dt < 2; ++dt) o[qg][dt] = MFMA32(vf[dt][ks], pf, o[qg][dt]);
            }
            if (!diag && __all(run < SB_THR)) done[qg] = true;
        }
        if (done[0] && done[1]) break;
    }
#pragma unroll
    for (int qg = 0; qg < 2; ++qg) { float s = 0.f;
#pragma unroll
        for (int dt = 0; dt < 2; ++dt)
#pragma unroll
            for (int r = 0; r < 16; ++r) s += o[qg][dt][r] * o[qg][dt][r];
        s += __shfl_xor(s, 32);
        if (hi == 0) red[h * 64 + 32 * qg + j] = s; }
    __syncthreads();
#pragma unroll
    for (int qg = 0; qg < 2; ++qg) { float tot = 0.f;
#pragma unroll
        for (int hh = 0; hh < 8; ++hh) tot += red[hh * 64 + 32 * qg + j];
        const float rb = 1.0f / sqrtf(tot * (1.0f / 512.0f) + EPS);
        bf16* orow = merged + (tb + q0 + 32 * qg + j) * 1024 + 512 + h * 64;
#pragma unroll
        for (int dt = 0; dt < 2; ++dt)
#pragma unroll
            for (int g = 0; g < 4; ++g) { const int d0 = dt * 32 + 8 * g + 4 * hi; const f32x4 gv = *(const f32x4*)(gb + h * 64 + d0);
                v2u w; w.x = cvtpk(o[qg][dt][4 * g] * rb * gv.x, o[qg][dt][4 * g + 1] * rb * gv.y); w.y = cvtpk(o[qg][dt][4 * g + 2] * rb * gv.z, o[qg][dt][4 * g + 3] * rb * gv.w);
                *(v2u*)(orow + d0) = w; } }
    __syncthreads();
}

__device__ __forceinline__ void sgu_unit(const bf16* U, const bf16* VG, const float* ng, const float* nb, const float* Ws, const float* bs, const float* og, bf16* merged,
                                         LAS unsigned char* lds, int unit, int tid) {
    const int b = unit >> 6, rem = unit & 63, c = rem >> 1, th = rem & 1;
    const size_t tok0 = (size_t)b * SEQ + (size_t)c * 128;
    const int slen = 64 * (th + 1);
    LAS float* Vn = (LAS float*)lds;
    LAS float* Wt = (LAS float*)(lds + 128 * 132 * 4);
    const int dq = tid & 31, tq = tid >> 5, wave = tid >> 6;
    float ssq[4] = {0.f, 0.f, 0.f, 0.f};
#pragma unroll 1
    for (int g = 0; g < 4; ++g) {
        __syncthreads();
        {
            const int s = tid >> 2, qd = tid & 3;
            if (s < slen) {
                const v4u* p = (const v4u*)(VG + (tok0 + s) * 512 + g * 128 + 32 * qd);
                float x[32];
#pragma unroll
                for (int i = 0; i < 4; ++i) { const v4u w = p[i]; x[8 * i] = bflo(w.x); x[8 * i + 1] = bfhi(w.x); x[8 * i + 2] = bflo(w.y); x[8 * i + 3] = bfhi(w.y);
                    x[8 * i + 4] = bflo(w.z); x[8 * i + 5] = bfhi(w.z); x[8 * i + 6] = bflo(w.w); x[8 * i + 7] = bfhi(w.w); }
                float sm = 0.f;
#pragma unroll
                for (int i = 0; i < 32; ++i) sm += x[i];
                sm += __shfl_xor(sm, 1); sm += __shfl_xor(sm, 2);
                const float mu = sm * (1.0f / 128.0f); float vs = 0.f;
#pragma unroll
                for (int i = 0; i < 32; ++i) { x[i] -= mu; vs += x[i] * x[i]; }
                vs += __shfl_xor(vs, 1); vs += __shfl_xor(vs, 2);
                const float rstd = 1.0f / sqrtf(vs * (1.0f / 128.0f) + EPS);
                const f32x4* gp = (const f32x4*)(ng + g * 128 + 32 * qd); const f32x4* bp = (const f32x4*)(nb + g * 128 + 32 * qd);
#pragma unroll
                for (int i = 0; i < 8; ++i) { const f32x4 gv = gp[i], bv = bp[i]; f32x4 y;
                    y.x = x[4 * i] * rstd * gv.x + bv.x; y.y = x[4 * i + 1] * rstd * gv.y + bv.y; y.z = x[4 * i + 2] * rstd * gv.z + bv.z; y.w = x[4 * i + 3] * rstd * gv.w + bv.w;
                    *(LAS f32x4*)(Vn + s * 132 + 32 * qd + 4 * i) = y; }
            }
        }
        {
            const int nq = slen >> 2;
            for (int idx = tid; idx < 64 * nq; idx += 512) { const int tl = idx & 63, quad = idx >> 6, s0 = 4 * quad, t = 64 * th + tl;
                const f32x4 w = *(const f32x4*)(Ws + (size_t)g * 128 * 128 + (size_t)t * 128 + s0);
                Wt[(s0 + 0) * 68 + tl] = (s0 + 0 <= t) ? w.x : 0.f; Wt[(s0 + 1) * 68 + tl] = (s0 + 1 <= t) ? w.y : 0.f;
                Wt[(s0 + 2) * 68 + tl] = (s0 + 2 <= t) ? w.z : 0.f; Wt[(s0 + 3) * 68 + tl] = (s0 + 3 <= t) ? w.w : 0.f; }
        }
        __syncthreads();
        float m[4][4];
#pragma unroll
        for (int ti = 0; ti < 4; ++ti)
#pragma unroll
            for (int di = 0; di < 4; ++di) m[ti][di] = 0.f;
        const int send = 64 * th + 8 * wave + 8;
        for (int s = 0; s < send; ++s) { const f32x4 wv = *(const LAS f32x4*)(Wt + s * 68 + 4 * tq); const f32x4 vv = *(const LAS f32x4*)(Vn + s * 132 + 4 * dq);
#pragma unroll
            for (int ti = 0; ti < 4; ++ti)
#pragma unroll
                for (int di = 0; di < 4; ++di) m[ti][di] += wv[ti] * vv[di]; }
#pragma unroll
        for (int ti = 0; ti < 4; ++ti) { const int t = 64 * th + 4 * tq + ti; const float bias = bs[g * 128 + t];
            const v2u uw = *(const v2u*)(U + (tok0 + t) * 512 + g * 128 + 4 * dq);
            const float o0 = bflo(uw.x) * (m[ti][0] + bias), o1 = bfhi(uw.x) * (m[ti][1] + bias), o2 = bflo(uw.y) * (m[ti][2] + bias), o3 = bfhi(uw.y) * (m[ti][3] + bias);
            ssq[ti] += (o0 * o0 + o1 * o1) + (o2 * o2 + o3 * o3);
            v2u w; w.x = cvtpk(o0, o1); w.y = cvtpk(o2, o3);
            *(v2u*)(merged + (tok0 + t) * 1024 + g * 128 + 4 * dq) = w; }
    }
    __threadfence();
#pragma unroll
    for (int ti = 0; ti < 4; ++ti) { float s = ssq[ti];
#pragma unroll
        for (int of = 1; of < 32; of <<= 1) s += __shfl_xor(s, of);
        const float rn = 1.0f / sqrtf(s * (1.0f / 512.0f) + EPS);
        const int t = 64 * th + 4 * tq + ti; bf16* orow = merged + (tok0 + t) * 1024;
#pragma unroll 1
        for (int g = 0; g < 4; ++g) { const f32x4 gv = *(const f32x4*)(og + g * 128 + 4 * dq);
            const v2u r = *(const v2u*)(orow + g * 128 + 4 * dq);
            v2u w; w.x = cvtpk(bflo(r.x) * rn * gv.x, bfhi(r.x) * rn * gv.y); w.y = cvtpk(bflo(r.y) * rn * gv.z, bfhi(r.y) * rn * gv.w);
            *(v2u*)(orow + g * 128 + 4 * dq) = w; } }
    __syncthreads();
}

__device__ __forceinline__ void xa_unit(const bf16* Qx, const bf16* Km, const bf16* VmT, bf16* Oc, LAS unsigned char* lds, int unit, int tid, int wave, int lane) {
    const int b = unit >> 7, h = (unit >> 5) & 3, qt = unit & 31, fr = lane & 15, fq = lane >> 4;
    const size_t tok = (size_t)b * SEQ + (size_t)qt * 128 + wave * 16 + fr;
    LAS unsigned char* Kl = lds;
    LAS unsigned char* Vl = lds + 33792;
    bf16x8 qf[8];
#pragma unroll
    for (int kk = 0; kk < 8; ++kk) qf[kk] = *(const bf16x8*)(Qx + tok * 1024 + h * 256 + 32 * kk + 8 * fq);
    f32x4 s[16];
#pragma unroll
    for (int i = 0; i < 16; ++i) s[i] = (f32x4){0.f, 0.f, 0.f, 0.f};
#pragma unroll
    for (int c = 0; c < 4; ++c) {
        __syncthreads();
#pragma unroll
        for (int i = 0; i < 4; ++i) { const int idx = tid + 512 * i, row = idx >> 5, piece = idx & 31;
            const v4u val = *(const v4u*)(Km + (size_t)(b * MEMLEN + c * 64 + row) * 1024 + h * 256 + piece * 8);
            *(LAS v4u*)(Kl + row * 528 + piece * 16) = val; }
        __syncthreads();
#pragma unroll
        for (int mt = 0; mt < 4; ++mt)
#pragma unroll
            for (int kk = 0; kk < 8; ++kk) { const bf16x8 a = *(const LAS bf16x8*)(Kl + (mt * 16 + fr) * 528 + (32 * kk + 8 * fq) * 2);
                s[c * 4 + mt] = MFMA16(a, qf[kk], s[c * 4 + mt]); }
    }
    float mx = -3.0e38f;
#pragma unroll
    for (int i = 0; i < 16; ++i) mx = __builtin_fmaxf(mx, __builtin_fmaxf(__builtin_fmaxf(s[i].x, s[i].y), __builtin_fmaxf(s[i].z, s[i].w)));
    mx = __builtin_fmaxf(mx, __shfl_xor(mx, 16)); mx = __builtin_fmaxf(mx, __shfl_xor(mx, 32));
    const float c2 = 0.0625f * LOG2E; float sum = 0.f;
#pragma unroll
    for (int i = 0; i < 16; ++i) { f32x4 p; p.x = __builtin_amdgcn_exp2f((s[i].x - mx) * c2); p.y = __builtin_amdgcn_exp2f((s[i].y - mx) * c2);
        p.z = __builtin_amdgcn_exp2f((s[i].z - mx) * c2); p.w = __builtin_amdgcn_exp2f((s[i].w - mx) * c2); s[i] = p; sum += (p.x + p.y) + (p.z + p.w); }
    sum += __shfl_xor(sum, 16); sum += __shfl_xor(sum, 32);
    const float inv = 1.0f / sum;
    bf16x8 pf[8];
#pragma unroll
    for (int sp = 0; sp < 8; ++sp) { v4u w; w.x = cvtpk(s[2 * sp].x, s[2 * sp].y); w.y = cvtpk(s[2 * sp].z, s[2 * sp].w); w.z = cvtpk(s[2 * sp + 1].x, s[2 * sp + 1].y); w.w = cvtpk(s[2 * sp + 1].z, s[2 * sp + 1].w);
        pf[sp] = __builtin_bit_cast(bf16x8, w); }
    f32x4 o[16];
#pragma unroll
    for (int i = 0; i < 16; ++i) o[i] = (f32x4){0.f, 0.f, 0.f, 0.f};
#pragma unroll
    for (int c = 0; c < 4; ++c) {
        __syncthreads();
#pragma unroll
        for (int i = 0; i < 4; ++i) { const int idx = tid + 512 * i, row = idx >> 3, piece = idx & 7;
            const v4u val = *(const v4u*)(VmT + (size_t)(h * 256 + row) * TM + b * MEMLEN + c * 64 + piece * 8);
            *(LAS v4u*)(Vl + row * 144 + piece * 16) = val; }
        __syncthreads();
#pragma unroll
        for (int s2 = 0; s2 < 2; ++s2)
#pragma unroll
            for (int dt = 0; dt < 16; ++dt) { const LAS unsigned char* vp = Vl + (dt * 16 + fr) * 144 + (32 * s2 + 4 * fq) * 2;
                const s16x4 lo = *(const LAS s16x4*)vp, h4 = *(const LAS s16x4*)(vp + 32);
                const bf16x8 a = (bf16x8){lo[0], lo[1], lo[2], lo[3], h4[0], h4[1], h4[2], h4[3]};
                o[dt] = MFMA16(a, pf[2 * c + s2], o[dt]); }
    }
    bf16* orow = Oc + tok * 1024 + h * 256;
#pragma unroll
    for (int dt = 0; dt < 16; ++dt) { v2u w; w.x = cvtpk(o[dt].x * inv, o[dt].y * inv); w.y = cvtpk(o[dt].z * inv, o[dt].w * inv); *(v2u*)(orow + dt * 16 + 4 * fq) = w; }
}
struct Args { const float* in[N_IN]; float* out; unsigned char* ws; int ph_lo, ph_hi; };
static_assert(sizeof(Args) == N_IN * 8 + 8 + 8 + 8, "Args has no padding bytes");
constexpr int N_PHASES = 15;

__global__ void __launch_bounds__(NWAVES * 64, 2) fwd_megakernel(Args args) {
    extern __shared__ __attribute__((aligned(16))) unsigned char lds_raw[];
    LAS unsigned char* lds = (LAS unsigned char*)lds_raw;
    const int tid = threadIdx.x, lane = tid & 63, wave = __builtin_amdgcn_readfirstlane(tid >> 6);
    const int G = gridDim.x, bx = blockIdx.x;
    const int gw = bx * NWAVES + wave, ngw = G * NWAVES;
    unsigned char* ws = args.ws;
    bf16* Wgu1 = (bf16*)(ws + WS_WGU1); bf16* Wd1 = (bf16*)(ws + WS_WD1); bf16* Win = (bf16*)(ws + WS_WIN); bf16* Wout = (bf16*)(ws + WS_WOUT); bf16* Wq = (bf16*)(ws + WS_WQ);
    bf16* Wkv = (bf16*)(ws + WS_WKV); bf16* Wo = (bf16*)(ws + WS_WO); bf16* Wgu2 = (bf16*)(ws + WS_WGU2); bf16* Wd2 = (bf16*)(ws + WS_WD2);
    bf16* MEMN = (bf16*)(ws + WS_MEMN); bf16* KMEM = (bf16*)(ws + WS_KMEM); bf16* VMT = (bf16*)(ws + WS_VMT);
    bf16* XN = (bf16*)(ws + WS_XN); bf16* HB = (bf16*)(ws + WS_HB);
    bf16* UB = (bf16*)(ws + WS_U); bf16* VGB = (bf16*)(ws + WS_VG); bf16* QB = (bf16*)(ws + WS_Q); bf16* KB = (bf16*)(ws + WS_KK); bf16* VTB = (bf16*)(ws + WS_VT);
    bf16* QX = (bf16*)(ws + WS_QX); bf16* OC = (bf16*)(ws + WS_OC);
    float* FB = (float*)(ws + WS_F); float* HA = args.out;
    const int lo = args.ph_lo, hi = args.ph_hi;
    volatile LAS unsigned* MISC = (volatile LAS unsigned*)(lds + RING_BYTES + 320);
    if (tid < 64) MISC[tid] = 0u;
    __syncthreads();
    XcdBarrier bar; bar.bar = (unsigned*)(ws + WS_CTL); bar.x = 0; bar.st = nullptr;
    if (hi - lo > 1) {
        cg::this_grid().sync();
        bar = xcd_barrier_post((unsigned*)(ws + WS_CTL), MISC + 8);
    }
#define IN(k) (lo <= (k) && (k) < hi)
#define SEAM(k) do { if (lo <= (k) && (k) + 1 < hi) xcd_barrier(bar); } while (0)
#define GEMM(EPI, g, S, E) pg8::gemm_phase<EPI, pg8::StaticOrder, PG8_ALIGN, PG8_SP2>(lds, g, S, E)

    if (IN(0)) {
        LAS float* scr = (LAS float*)(lds + wave * 16384);
        constexpr int I_GU = (D / 64) * (FF / 32), I_DN = (FF / 64) * (D / 32), I_IN = (D / 64) * (2560 / 32), I_SQ = (D / 64) * (D / 32), I_KV = (D / 64) * (2048 / 32);
        constexpr int NITEMS = 4 * I_GU + 2 * I_DN + I_IN + 3 * I_SQ + I_KV;
        for (int it = gw; it < NITEMS; it += ngw) {
            int r = it;
            if (r < I_GU) { transpose_mat(args.in[I_F1WG], D, FF, Wgu1, 1, r, scr, lane); continue; } r -= I_GU;
            if (r < I_GU) { transpose_mat(args.in[I_F1WU], D, FF, Wgu1, 2, r, scr, lane); continue; } r -= I_GU;
            if (r < I_DN) { transpose_mat(args.in[I_F1WD], FF, D, Wd1, 0, r, scr, lane); continue; } r -= I_DN;
            if (r < I_IN) { transpose_mat(args.in[I_WIN], D, 2560, Win, 0, r, scr, lane); continue; } r -= I_IN;
            if (r < I_SQ) { transpose_mat(args.in[I_WOUT], D, D, Wout, 0, r, scr, lane); continue; } r -= I_SQ;
            if (r < I_SQ) { transpose_mat(args.in[I_XAWQ], D, D, Wq, 0, r, scr, lane); continue; } r -= I_SQ;
            if (r < I_KV) { transpose_mat(args.in[I_XAWKV], D, 2048, Wkv, 0, r, scr, lane); continue; } r -= I_KV;
            if (r < I_SQ) { transpose_mat(args.in[I_XAWO], D, D, Wo, 0, r, scr, lane); continue; } r -= I_SQ;
            if (r < I_GU) { transpose_mat(args.in[I_F2WG], D, FF, Wgu2, 1, r, scr, lane); continue; } r -= I_GU;
            if (r < I_GU) { transpose_mat(args.in[I_F2WU], D, FF, Wgu2, 2, r, scr, lane); continue; } r -= I_GU;
            transpose_mat(args.in[I_F2WD], FF, D, Wd2, 0, r, scr, lane);
        }
        rows_norm_bf16(args.in[I_X], args.in[I_F1PRE], XN, T, gw, ngw, lane);
        rows_norm_bf16(args.in[I_MEM], args.in[I_MEMG], MEMN, TM, gw, ngw, lane);
    }
    SEAM(0);
    if (IN(1)) {
        { pg8::Gemm g{XN, Wgu1, T, 2 * FF, D}; pg8::StaticOrder S; S.init(T, 2 * FF, G, bx); pg8::EpiSwiGLU E{HB, FF}; GEMM(pg8::EpiSwiGLU, g, S, E); }
        const int sb = (G == 256) ? bx - 128 : bx;
        { pg8::Gemm g{MEMN, Wkv, TM, 1024, D}; pg8::StaticOrder S; S.init(TM, 1024, G, (sb >= 0 && sb < 16) ? sb : (1 << 20)); pg8::EpiBf16P E{KMEM, 1024, 0, 0, 0}; GEMM(pg8::EpiBf16P, g, S, E); }
        { pg8::Gemm g{Wkv + (size_t)1024 * D, MEMN, 1024, TM, D}; pg8::StaticOrder S; S.init(1024, TM, G, (sb >= 16 && sb < 32) ? sb - 16 : (1 << 20)); pg8::EpiBf16P E{VMT, TM, 0, 0, 0}; GEMM(pg8::EpiBf16P, g, S, E); }
    }
    SEAM(1);
    if (IN(2)) { pg8::Gemm g{HB, Wd1, T, D, FF}; pg8::StaticOrder S; S.init(T, D, G, bx); pg8::EpiF32 E{FB, D}; GEMM(pg8::EpiF32, g, S, E); }
    SEAM(2);
    if (IN(3)) rows_resid<false>(args.in[I_X], FB, 0.5f, args.in[I_F1POST], args.in[I_MIXPRE], HA, XN, gw, ngw, lane);
    SEAM(3);
    if (IN(4)) {
        { pg8::Gemm g{XN, Win, T, 2048, D}; pg8::StaticOrder S; S.init(T, 2048, G, bx); pg8::EpiBf16P E{UB, 512, 512, (size_t)(WS_VG - WS_U) / 2, 2}; GEMM(pg8::EpiBf16P, g, S, E); }
        { pg8::Gemm g{Win + (size_t)2048 * D, XN, 512, T, D}; pg8::StaticOrder S; S.init(512, T, G, bx); pg8::EpiBf16P E{VTB, T, 0, 0, 0}; GEMM(pg8::EpiBf16P, g, S, E); }
    }
    SEAM(4);
    if (IN(5)) {
        for (int u = bx; u < 256; u += G) sb_unit(QB, KB, VTB, args.in[I_SB_OG], XN, (LAS float*)lds, u, wave, lane);
        for (int u = bx; u < 256; u += G) sgu_unit(UB, VGB, args.in[I_SGU_NG], args.in[I_SGU_NB], args.in[I_SGU_WS], args.in[I_SGU_BS], args.in[I_SGU_OG], XN, lds, u, tid);
    }
    SEAM(5);
    if (IN(6)) { pg8::Gemm g{XN, Wout, T, D, D}; pg8::StaticOrder S; S.init(T, D, G, bx); pg8::EpiF32 E{FB, D}; GEMM(pg8::EpiF32, g, S, E); }
    SEAM(6);
    if (IN(7)) rows_resid<false>(HA, FB, 1.0f, args.in[I_MIXPOST], args.in[I_XAPRE], HA, XN, gw, ngw, lane);
    SEAM(7);
    if (IN(8)) { pg8::Gemm g{XN, Wq, T, D, D}; pg8::StaticOrder S; S.init(T, D, G, bx); pg8::EpiBf16P E{QX, D, 0, 0, 0}; GEMM(pg8::EpiBf16P, g, S, E); }
    SEAM(8);
    if (IN(9)) { for (int u = bx; u < 512; u += G) xa_unit(QX, KMEM, VMT, OC, lds, u, tid, wave, lane); }
    SEAM(9);
    if (IN(10)) { pg8::Gemm g{OC, Wo, T, D, D}; pg8::StaticOrder S; S.init(T, D, G, bx); pg8::EpiF32 E{FB, D}; GEMM(pg8::EpiF32, g, S, E); }
    SEAM(10);
    if (IN(11)) rows_resid<false>(HA, FB, 1.0f, args.in[I_XAPOST], args.in[I_F2PRE], HA, XN, gw, ngw, lane);
    SEAM(11);
    if (IN(12)) { pg8::Gemm g{XN, Wgu2, T, 2 * FF, D}; pg8::StaticOrder S; S.init(T, 2 * FF, G, bx); pg8::EpiSwiGLU E{HB, FF}; GEMM(pg8::EpiSwiGLU, g, S, E); }
    SEAM(12);
    if (IN(13)) { pg8::Gemm g{HB, Wd2, T, D, FF}; pg8::StaticOrder S; S.init(T, D, G, bx); pg8::EpiF32 E{FB, D}; GEMM(pg8::EpiF32, g, S, E); }
    SEAM(13);
    if (IN(14)) rows_resid<true>(HA, FB, 0.5f, args.in[I_F2POST], args.in[I_FINAL], HA, nullptr, gw, ngw, lane);
#undef IN
#undef SEAM
#undef GEMM
}

extern "C" void kernel_launch(void* const* d_in, const int* in_sizes, int n_in, void* d_out, int out_size, void* d_ws, size_t ws_size, hipStream_t stream) {
    static int grid = 0;
    if (grid == 0) {
        if (n_in != N_IN || out_size != T * D || ws_size < WS_END) { fprintf(stderr, "kernel_launch: unexpected problem (n_in %d out %d ws %zu); nothing launched\n", n_in, out_size, ws_size); grid = -1; return; }
        int dev = 0, cus = 0, per_cu = 0;
        hipGetDevice(&dev); hipDeviceGetAttribute(&cus, hipDeviceAttributeMultiprocessorCount, dev);
        if (hipFuncSetAttribute((const void*)fwd_megakernel, hipFuncAttributeMaxDynamicSharedMemorySize, LDS_BYTES) != hipSuccess) { fprintf(stderr, "kernel_launch: hipFuncSetAttribute failed\n"); grid = -1; return; }
        if (hipOccupancyMaxActiveBlocksPerMultiprocessor(&per_cu, (const void*)fwd_megakernel, NWAVES * 64, LDS_BYTES) != hipSuccess || per_cu < 1) { fprintf(stderr, "kernel_launch: occupancy query says %d\n", per_cu); per_cu = 1; }
        (void)hipGetLastError();
        grid = cus * per_cu; if (grid > 256) grid = 256;
        fprintf(stderr, "kernel_launch: grid %d (cus %d, per_cu %d)\n", grid, cus, per_cu);
    }
    if (grid < 0) return;
    if (hipMemsetAsync((char*)d_ws + WS_CTL, 0, CTL_ZERO_BYTES, stream) != hipSuccess) { fprintf(stderr, "kernel_launch: memset failed\n"); return; }
    Args a{};
    for (int i = 0; i < N_IN; ++i) a.in[i] = (const float*)d_in[i];
    a.out = (float*)d_out; a.ws = (unsigned char*)d_ws;
#if MK_PER_PHASE
    for (int p = 0; p < N_PHASES; ++p) { a.ph_lo = p; a.ph_hi = p + 1; hipLaunchKernelGGL(fwd_megakernel, dim3(grid), dim3(NWAVES * 64), LDS_BYTES, stream, a); }
#else
    a.ph_lo = 0; a.ph_hi = N_PHASES;
    void* kargs[] = {&a};
    hipError_t e = hipLaunchCooperativeKernel((const void*)fwd_megakernel, dim3(grid), dim3(NWAVES * 64), kargs, LDS_BYTES, stream);
    if (e != hipSuccess) fprintf(stderr, "kernel_launch: cooperative launch failed: %s (grid %d)\n", hipGetErrorString(e), grid);
#endif
}
```

```cpp
#include <hip/hip_runtime.h>
#include <hip/hip_cooperative_groups.h>
#include <cstdio>
#include <cstdint>
namespace cg = cooperative_groups;
namespace pg8 {
#define PG8_LAS __attribute__((address_space(3)))
typedef unsigned short bf16_t;
typedef short bf16x8 __attribute__((ext_vector_type(8)));
typedef float f32x4 __attribute__((ext_vector_type(4)));
typedef unsigned u32x4 __attribute__((ext_vector_type(4)));
constexpr int BM = 256, BK = 64, HALF = 128, HTB = HALF * BK * 2  , STAGE_BYTES = 8 * HTB, NXCD = 8, WGM = 8;

__host__ __device__ __forceinline__ int lds_byte(int r, int c) { const int st = (r >> 4) * 2 + (c >> 5), rr = r & 15, cc = c & 31, ob = rr * 64 + cc * 2; return st * 1024 + (ob ^ (((ob >> 9) & 1) << 5)); }
__host__ __device__ __forceinline__ void stage_rc(int b, int& R, int& C) { const int st = b / 1024, sb = b % 1024, swz = sb ^ (((sb >> 9) & 1) << 5); R = (st >> 1) * 16 + swz / 64; C = (st & 1) * 32 + (swz % 64) / 2; }
__host__ __device__ __forceinline__ int perm32(int rho) { const int n = rho >> 4, i = rho & 15; return 8 * (i >> 2) + 4 * n + (i & 3); }

struct Unit { int pm, pn; };
struct Gemm { const bf16_t* A; const bf16_t* Bt; int M, N, K; };

struct StaticOrder {
    int nM, nN, nwg, G, c;
    __host__ __device__ void init(int M, int N, int G_, int c_) { nM = M / BM; nN = N / BM; nwg = nM * nN; G = G_; c = c_; }
    __host__ __device__ bool next(int i, Unit& u) const {
        const long L = (long)i * G + c; if (L >= nwg) return false;
        int wgid = (int)L; { const int q = nwg / NXCD, r = nwg % NXCD, xcd = wgid % NXCD, off = wgid / NXCD; wgid = (xcd < r ? xcd * (q + 1) : r * (q + 1) + (xcd - r) * q) + off; }
        const int nig = WGM * nN, gid = wgid / nig, fm = gid * WGM, gsz = (nM - fm) < WGM ? (nM - fm) : WGM;
        u.pm = fm + ((wgid % nig) % gsz); u.pn = (wgid % nig) / gsz; return true;
    }
    __device__ __forceinline__ void a_ready(const Unit&) const {}
    __device__ __forceinline__ void done(const Unit&) const {}
};

__device__ __forceinline__ unsigned cvt_pk_bf16(float lo, float hi) { unsigned r; asm volatile("v_cvt_pk_bf16_f32 %0, %1, %2" : "=v"(r) : "v"(lo), "v"(hi)); return r; }
typedef float f32x2 __attribute__((ext_vector_type(2)));
__device__ __forceinline__ float sigmoid_l2(float t) { return __builtin_amdgcn_rcpf(1.0f + __builtin_amdgcn_exp2f(-t)); }
__device__ __forceinline__ float silu_f(float g) { return g * sigmoid_l2(g * 1.4426950408889634f); }
__device__ __forceinline__ float gelu_tanh_f(float x) { const float u = x + 0.044715f * x * x * x; return x * sigmoid_l2(u * (2.0f * 0.7978845608028654f * 1.4426950408889634f)); }

struct EpiF32 {
    static constexpr bool PERM = false, AFTER_DRAIN = false;
    float* C; int ldc;
    __device__ __forceinline__ void operator()(const f32x4 (&acc)[2][2][4][2], const Unit& u, int wr, int wc, int fr, int fq) const {
        const int row0 = u.pm * BM + wr * 64 + fr, col0 = u.pn * BM + wc * 32 + 4 * fq;
#pragma unroll
        for (int ai = 0; ai < 2; ++ai)
#pragma unroll
            for (int m = 0; m < 4; ++m) { float* rowp = C + (size_t)(row0 + ai * HALF + m * 16) * ldc + col0;
#pragma unroll
                for (int bj = 0; bj < 2; ++bj)
#pragma unroll
                    for (int n = 0; n < 2; ++n) *(f32x4*)(rowp + bj * HALF + n * 16) = acc[ai][bj][m][n]; }
    }
};
struct EpiBf16P {
    static constexpr bool PERM = true, AFTER_DRAIN = false;
    bf16_t* O; int ldc; int split_cols; size_t split_stride; int n_gelu;
    __device__ __forceinline__ void operator()(const f32x4 (&acc)[2][2][4][2], const Unit& u, int wr, int wc, int fr, int fq) const {
        const int row0 = u.pm * BM + wr * 64 + fr; int colt = u.pn * BM; bf16_t* base = O; bool act = (split_cols == 0 && n_gelu > 0);
        if (split_cols) { const int t = colt / split_cols; base += (size_t)t * split_stride; colt -= t * split_cols; act = t < n_gelu; }
        const int col0 = colt + wc * 32 + 8 * fq;
#pragma unroll
        for (int ai = 0; ai < 2; ++ai)
#pragma unroll
            for (int m = 0; m < 4; ++m) { bf16_t* rowp = base + (size_t)(row0 + ai * HALF + m * 16) * ldc + col0;
#pragma unroll
                for (int bj = 0; bj < 2; ++bj) { f32x4 v0 = acc[ai][bj][m][0], v1 = acc[ai][bj][m][1];
                    if (act) {
#pragma unroll
                        for (int j = 0; j < 4; ++j) { v0[j] = gelu_tanh_f(v0[j]); v1[j] = gelu_tanh_f(v1[j]); } }
                    u32x4 w; w.x = cvt_pk_bf16(v0[0], v0[1]); w.y = cvt_pk_bf16(v0[2], v0[3]); w.z = cvt_pk_bf16(v1[0], v1[1]); w.w = cvt_pk_bf16(v1[2], v1[3]);
                    *(u32x4*)(rowp + bj * HALF) = w; } }
    }
};
struct EpiSwiGLU {
    static constexpr bool PERM = true, AFTER_DRAIN = false;
    bf16_t* H; int ldh;
    __device__ __forceinline__ void operator()(const f32x4 (&acc)[2][2][4][2], const Unit& u, int wr, int wc, int fr, int fq) const {
        const int row0 = u.pm * BM + wr * 64 + fr, col0 = u.pn * HALF + wc * 32 + 8 * fq;
#pragma unroll
        for (int ai = 0; ai < 2; ++ai)
#pragma unroll
            for (int m = 0; m < 4; ++m) { bf16_t* rowp = H + (size_t)(row0 + ai * HALF + m * 16) * ldh + col0;
                f32x4 h0, h1;
#pragma unroll
                for (int j = 0; j < 4; ++j) { h0[j] = silu_f(acc[ai][0][m][0][j]) * acc[ai][1][m][0][j]; h1[j] = silu_f(acc[ai][0][m][1][j]) * acc[ai][1][m][1][j]; }
                u32x4 w; w.x = cvt_pk_bf16(h0[0], h0[1]); w.y = cvt_pk_bf16(h0[2], h0[3]); w.z = cvt_pk_bf16(h1[0], h1[1]); w.w = cvt_pk_bf16(h1[2], h1[3]);
                *(u32x4*)rowp = w; }
    }
};
template <class Epi, class Sched, bool ALIGN_EPI = false, bool SP2 = false>
__device__ __forceinline__ void gemm_phase(PG8_LAS unsigned char* lds, const Gemm g, const Sched& S, const Epi& E) {
    const int tid = threadIdx.x, wid = __builtin_amdgcn_readfirstlane(tid >> 6), lane = tid & 63, wr = wid >> 2, wc = wid & 3, fr = lane & 15, fq = lane >> 4;
    const int K = g.K, nt = K / BK;
    unsigned voffA[2], voffB[2];
#pragma unroll
    for (int i = 0; i < 2; ++i) { int R, C; stage_rc(tid * 16 + i * 8192, R, C); const int Rb = Epi::PERM ? ((R & ~31) + perm32(R & 31)) : R;
        voffA[i] = (unsigned)(R * K + C) * 2u; voffB[i] = (unsigned)(Rb * K + C) * 2u; }
    const size_t kstep = (size_t)(BK * 2);
    const size_t hstep = (size_t)HALF * K * 2;
    const size_t tstep = 2 * hstep;
    const unsigned ldsw = (unsigned)wid * 1024u;
    const int aoff = lds_byte(wr * 64 + fr, fq * 8), boff = lds_byte(wc * 32 + fr, fq * 8);
#define PG8_SA(b, h) (((b) * 2 + (h)) * HTB)
#define PG8_SB(b, h) ((4 + (b) * 2 + (h)) * HTB)
#define PG8_STAGE(bufoff, gbase, voff) do { _Pragma("unroll") for (int _i = 0; _i < 2; ++_i) \
        __builtin_amdgcn_global_load_lds((const unsigned*)((const char*)(gbase) + (voff)[_i]), (PG8_LAS unsigned*)(lds + (bufoff) + ldsw + _i * 8192), 16, 0, 0); } while (0)
#define PG8_LDA(dst, b, h) do { _Pragma("unroll") for (int m = 0; m < 4; ++m) _Pragma("unroll") for (int k = 0; k < 2; ++k) dst[m][k] = *(const PG8_LAS bf16x8*)(lds + PG8_SA(b, h) + aoff + m * 2048 + k * 1024); } while (0)
#define PG8_LDB(dst, b, h) do { _Pragma("unroll") for (int n = 0; n < 2; ++n) _Pragma("unroll") for (int k = 0; k < 2; ++k) dst[n][k] = *(const PG8_LAS bf16x8*)(lds + PG8_SB(b, h) + boff + n * 2048 + k * 1024); } while (0)
#define PG8_MMA(ai, bj, At, Bt) do { __builtin_amdgcn_s_setprio(1); _Pragma("unroll") for (int m = 0; m < 4; ++m) _Pragma("unroll") for (int n = 0; n < 2; ++n) _Pragma("unroll") for (int k = 0; k < 2; ++k) \
        acc[ai][bj][m][n] = __builtin_amdgcn_mfma_f32_16x16x32_bf16(Bt[n][k], At[m][k], acc[ai][bj][m][n], 0, 0, 0); __builtin_amdgcn_s_setprio(0); } while (0)
#define PG8_WAIT_V(n) asm volatile("s_waitcnt vmcnt(" #n ")" ::: "memory")
#define PG8_WAIT_L(n) asm volatile("s_waitcnt lgkmcnt(" #n ")" ::: "memory")
#define PG8_BAR __builtin_amdgcn_s_barrier()
#define PG8_SCHED __builtin_amdgcn_sched_barrier(0)
    Unit cur, nxt; int ui = 0;
    if (!S.next(0, cur)) return;
    f32x4 acc[2][2][4][2];
#pragma unroll
    for (int a = 0; a < 2; ++a)
#pragma unroll
        for (int b = 0; b < 2; ++b)
#pragma unroll
            for (int m = 0; m < 4; ++m)
#pragma unroll
                for (int n = 0; n < 2; ++n) acc[a][b][m][n] = (f32x4){0.f, 0.f, 0.f, 0.f};
    bf16x8 At[4][2], B0[2][2], B1[2][2];
    const char* cA = (const char*)g.A + (size_t)cur.pm * tstep; const char* cB = (const char*)g.Bt + (size_t)cur.pn * tstep;
    S.a_ready(cur);
    if constexpr (SP2) {
        PG8_STAGE(PG8_SB(0, 0), cB, voffB); PG8_STAGE(PG8_SB(0, 1), cB + hstep, voffB); PG8_STAGE(PG8_SA(0, 0), cA, voffA); PG8_STAGE(PG8_SA(0, 1), cA + hstep, voffA);
        if (wr == 1) PG8_BAR;
        PG8_WAIT_V(2); PG8_BAR;
        PG8_STAGE(PG8_SB(1, 0), cB + kstep, voffB); PG8_STAGE(PG8_SA(1, 0), cA + kstep, voffA); PG8_STAGE(PG8_SB(1, 1), cB + hstep + kstep, voffB);
        PG8_WAIT_V(6); PG8_BAR;
    } else {
        PG8_STAGE(PG8_SB(0, 0), cB, voffB); PG8_STAGE(PG8_SA(0, 0), cA, voffA); PG8_STAGE(PG8_SB(0, 1), cB + hstep, voffB); PG8_STAGE(PG8_SA(0, 1), cA + hstep, voffA);
        if (wr == 1) PG8_BAR;
        PG8_WAIT_V(4); PG8_BAR;
        PG8_STAGE(PG8_SB(1, 0), cB + kstep, voffB); PG8_STAGE(PG8_SA(1, 0), cA + kstep, voffA); PG8_STAGE(PG8_SB(1, 1), cB + hstep + kstep, voffB);
        PG8_WAIT_V(6); PG8_BAR;
    }
    for (;;) {
        const bool has_next = S.next(ui + 1, nxt);
        const char* nA = has_next ? (const char*)g.A + (size_t)nxt.pm * tstep : cA; const char* nB = has_next ? (const char*)g.Bt + (size_t)nxt.pn * tstep : cB;
        for (int t = 0; t < nt; t += 2) {
            const bool last = (t == nt - 2);
            const char* a1 = cA + (size_t)(t + 1) * kstep;
            const char* a2 = last ? nA : cA + (size_t)(t + 2) * kstep; const char* b2 = last ? nB : cB + (size_t)(t + 2) * kstep;
            const char* a3 = a2 + kstep; const char* b3 = b2 + kstep;
            if (last && has_next) S.a_ready(nxt);
            if constexpr (SP2) {
            PG8_LDB(B0, 0, 0); PG8_LDB(B1, 0, 1); PG8_SCHED; PG8_LDA(At, 0, 0); PG8_STAGE(PG8_SA(1, 1), a1 + hstep, voffA);
            PG8_WAIT_V(8); PG8_WAIT_L(0); PG8_BAR; PG8_MMA(0, 0, At, B0); PG8_MMA(0, 1, At, B1); PG8_BAR; PG8_SCHED;
            PG8_LDA(At, 0, 1); PG8_STAGE(PG8_SB(0, 0), b2, voffB); PG8_STAGE(PG8_SB(0, 1), b2 + hstep, voffB); PG8_STAGE(PG8_SA(0, 0), a2, voffA);
            PG8_WAIT_V(8); PG8_WAIT_L(0); PG8_BAR; PG8_MMA(1, 0, At, B0); PG8_MMA(1, 1, At, B1); PG8_BAR; PG8_SCHED;
            PG8_LDB(B0, 1, 0); PG8_LDB(B1, 1, 1); PG8_SCHED; PG8_LDA(At, 1, 0); PG8_STAGE(PG8_SA(0, 1), a2 + hstep, voffA);
            PG8_WAIT_V(8); PG8_WAIT_L(0); PG8_BAR; PG8_MMA(0, 0, At, B0); PG8_MMA(0, 1, At, B1); PG8_BAR; PG8_SCHED;
            PG8_LDA(At, 1, 1); PG8_STAGE(PG8_SB(1, 0), b3, voffB); PG8_STAGE(PG8_SB(1, 1), b3 + hstep, voffB); PG8_STAGE(PG8_SA(1, 0), a3, voffA);
            PG8_WAIT_V(8); PG8_WAIT_L(0); PG8_BAR; PG8_MMA(1, 0, At, B0); PG8_MMA(1, 1, At, B1); PG8_BAR; PG8_SCHED;
            } else {
            PG8_LDB(B0, 0, 0); PG8_SCHED; PG8_LDA(At, 0, 0); PG8_STAGE(PG8_SA(1, 1), a1 + hstep, voffA);
            PG8_WAIT_L(8); PG8_BAR; PG8_WAIT_L(0); PG8_MMA(0, 0, At, B0); PG8_BAR; PG8_SCHED;
            PG8_LDB(B1, 0, 1); PG8_STAGE(PG8_SB(0, 0), b2, voffB);
            PG8_BAR; PG8_WAIT_L(0); PG8_MMA(0, 1, At, B1); PG8_BAR;
            PG8_LDA(At, 0, 1); PG8_STAGE(PG8_SA(0, 0), a2, voffA);
            PG8_BAR; PG8_WAIT_L(0); PG8_MMA(1, 0, At, B0); PG8_BAR; PG8_SCHED;
            PG8_STAGE(PG8_SB(0, 1), b2 + hstep, voffB);
            PG8_WAIT_V(6); PG8_BAR; PG8_MMA(1, 1, At, B1); PG8_BAR;
            PG8_LDB(B0, 1, 0); PG8_SCHED; PG8_LDA(At, 1, 0); PG8_STAGE(PG8_SA(0, 1), a2 + hstep, voffA);
            PG8_WAIT_L(8); PG8_BAR; PG8_WAIT_L(0); PG8_MMA(0, 0, At, B0); PG8_BAR; PG8_SCHED;
            PG8_LDB(B1, 1, 1); PG8_STAGE(PG8_SB(1, 0), b3, voffB);
            PG8_BAR; PG8_WAIT_L(0); PG8_MMA(0, 1, At, B1); PG8_BAR;
            PG8_LDA(At, 1, 1); PG8_STAGE(PG8_SA(1, 0), a3, voffA);
            PG8_BAR; PG8_WAIT_L(0); PG8_MMA(1, 0, At, B0); PG8_BAR; PG8_SCHED;
            PG8_STAGE(PG8_SB(1, 1), b3 + hstep, voffB);
            PG8_WAIT_V(6); PG8_BAR; PG8_MMA(1, 1, At, B1); PG8_BAR;
            }
        }
        if constexpr (ALIGN_EPI) { if (wr == 0) PG8_BAR; }
        if constexpr (!Epi::AFTER_DRAIN) { E(acc, cur, wr, wc, fr, fq); S.done(cur); }
        if (!has_next) break;
#pragma unroll
        for (int a = 0; a < 2; ++a)
#pragma unroll
            for (int b = 0; b < 2; ++b)
#pragma unroll
                for (int m = 0; m < 4; ++m)
#pragma unroll
                    for (int n = 0; n < 2; ++n) acc[a][b][m][n] = (f32x4){0.f, 0.f, 0.f, 0.f};
        cur = nxt; cA = nA; cB = nB; ++ui;
        if constexpr (ALIGN_EPI) { if (wr == 1) PG8_BAR; }
    }
    PG8_WAIT_V(0);
    if constexpr (!ALIGN_EPI) { if (wr == 0) PG8_BAR; }
    PG8_BAR;
    if constexpr (Epi::AFTER_DRAIN) { E.fused(acc, cur, wr, wc, fr, fq, lds, wid, lane); S.done(cur); }
#undef PG8_SA
#undef PG8_SB
#undef PG8_STAGE
#undef PG8_LDA
#undef PG8_LDB
#undef PG8_MMA
#undef PG8_WAIT_V
#undef PG8_WAIT_L
#undef PG8_BAR
#undef PG8_SCHED
}
}
#ifndef PG8_SP2
#define PG8_SP2 true
#endif
#ifndef PG8_ALIGN
#define PG8_ALIGN true
#endif
#ifndef MK_PER_PHASE
#define MK_PER_PHASE 0
#endif

constexpr int NWAVES = 8;
constexpr int BATCH = 4, SEQ = 4096, D = 1024, FF = 2816, T = BATCH * SEQ, MEMLEN = 256, TM = BATCH * MEMLEN;
constexpr float EPS = 1e-6f;
constexpr float LOG2E = 1.4426950408889634f;
enum { I_X = 0, I_MEM, I_F1PRE, I_F1POST, I_F1WG, I_F1WU, I_F1WD, I_MIXPRE, I_MIXPOST, I_WIN, I_SGU_NG, I_SGU_NB, I_SGU_WS, I_SGU_BS, I_SGU_OG, I_SB_OG, I_WOUT,
       I_XAPRE, I_XAPOST, I_MEMG, I_XAWQ, I_XAWKV, I_XAWO, I_F2PRE, I_F2POST, I_F2WG, I_F2WU, I_F2WD, I_FINAL, N_IN };
constexpr size_t MiB = 1u << 20;
constexpr size_t WS_CTL = 0, CTL_ZERO_BYTES = 16384;
constexpr size_t WS_WGU1 = 2 * MiB, WS_WD1 = 13 * MiB, WS_WIN = 18 * MiB + 512 * 1024, WS_WOUT = 23 * MiB + 512 * 1024, WS_WQ = 25 * MiB + 512 * 1024,
                 WS_WKV = 27 * MiB + 512 * 1024, WS_WO = 31 * MiB + 512 * 1024, WS_WGU2 = 33 * MiB + 512 * 1024, WS_WD2 = 44 * MiB + 512 * 1024;
constexpr size_t WS_MEMN = 50 * MiB, WS_KMEM = 52 * MiB, WS_VMT = 54 * MiB;
constexpr size_t WS_XN = 56 * MiB;
constexpr size_t WS_HB = 88 * MiB;
constexpr size_t WS_U = 88 * MiB, WS_VG = 104 * MiB, WS_Q = 120 * MiB, WS_KK = 136 * MiB, WS_VT = 152 * MiB;
constexpr size_t WS_QX = 88 * MiB, WS_OC = 120 * MiB;
constexpr size_t WS_VGT = 168 * MiB;
constexpr size_t WS_F = 184 * MiB, WS_END = 248 * MiB;
static_assert(WS_WGU1 + (size_t)2 * FF * D * 2 <= WS_WD1 && WS_WD1 + (size_t)D * FF * 2 <= WS_WIN && WS_WIN + (size_t)2560 * D * 2 <= WS_WOUT && WS_WGU2 + (size_t)2 * FF * D * 2 <= WS_WD2 && WS_WD2 + (size_t)D * FF * 2 <= WS_MEMN, "ws map");
static_assert(WS_HB + (size_t)T * FF * 2 <= WS_F && WS_VGT + (size_t)512 * T * 2 <= WS_F, "ws map");

constexpr int LDS_BYTES = 147456;
constexpr int RING_BYTES = 131072;

#define GAS __attribute__((address_space(1)))
#define LAS __attribute__((address_space(3)))
typedef unsigned short bf16;
typedef unsigned v4u __attribute__((ext_vector_type(4)));
typedef unsigned v2u __attribute__((ext_vector_type(2)));
typedef float f32x4 __attribute__((ext_vector_type(4)));
typedef float f32x16 __attribute__((ext_vector_type(16)));
typedef short bf16x8 __attribute__((ext_vector_type(8)));
typedef short s16x4 __attribute__((ext_vector_type(4)));
typedef __bf16 bf16x2_t __attribute__((ext_vector_type(2)));
typedef float f32x2_t __attribute__((ext_vector_type(2)));
#define LDS_WAIT() asm volatile("s_waitcnt lgkmcnt(0)" ::: "memory")
#define MFMA32(a, b, c) __builtin_amdgcn_mfma_f32_32x32x16_bf16((a), (b), (c), 0, 0, 0)
#define MFMA16(a, b, c) __builtin_amdgcn_mfma_f32_16x16x32_bf16((a), (b), (c), 0, 0, 0)
__device__ __forceinline__ unsigned f2bf(float f) { unsigned u = __builtin_bit_cast(unsigned, f); return (u + 0x7fffu + ((u >> 16) & 1u)) >> 16; }
__device__ __forceinline__ unsigned pk2(float lo, float hi) { return f2bf(lo) | (f2bf(hi) << 16); }
__device__ __forceinline__ unsigned cvtpk(float lo, float hi) { f32x2_t v = {lo, hi}; bf16x2_t b = __builtin_convertvector(v, bf16x2_t); return __builtin_bit_cast(unsigned, b); }
__device__ __forceinline__ float bflo(unsigned w) { return __builtin_bit_cast(float, w << 16); }
__device__ __forceinline__ float bfhi(unsigned w) { return __builtin_bit_cast(float, w & 0xffff0000u); }
__device__ __forceinline__ float wave_sum(float v) {
#pragma unroll
    for (int o = 1; o < 64; o <<= 1) v += __shfl_xor(v, o);
    return v;
}
__device__ __forceinline__ int crow(int r, int hi) { return (r & 3) + 8 * (r >> 2) + 4 * hi; }

__device__ __forceinline__ void transpose_item(const float* W, int K, int N, bf16* WT, int k0, int n0, int dst_row0, LAS float* scr, int lane) {
#pragma unroll 8
    for (int i = 0; i < 32; ++i) { const int kk = 2 * i + (lane >> 5); scr[kk * 33 + (lane & 31)] = W[(size_t)(k0 + kk) * N + n0 + (lane & 31)]; }
    LDS_WAIT(); asm volatile("" ::: "memory");
    const int c = lane & 7;
#pragma unroll
    for (int j = 0; j < 4; ++j) { const int n = (lane >> 3) + 8 * j; const LAS float* s = scr + (8 * c) * 33 + n;
        v4u o; o.x = pk2(s[0 * 33], s[1 * 33]); o.y = pk2(s[2 * 33], s[3 * 33]); o.z = pk2(s[4 * 33], s[5 * 33]); o.w = pk2(s[6 * 33], s[7 * 33]);
        *(v4u*)(WT + (size_t)(dst_row0 + n) * K + k0 + 8 * c) = o; }
    LDS_WAIT(); asm volatile("" ::: "memory");
}
__device__ __forceinline__ void transpose_mat(const float* W, int K, int N, bf16* WT, int mode, int item, LAS float* scr, int lane) {
    const int nblk = N / 32, kb = item / nblk, nb = item % nblk, n0 = 32 * nb;
    const int dst = mode == 0 ? n0 : ((n0 >> 7) * 256 + (n0 & 127) + (mode == 2 ? 128 : 0));
    transpose_item(W, K, N, WT, 64 * kb, n0, dst, scr, lane);
}

struct Row { f32x4 v[4]; };
__device__ __forceinline__ Row row_load(const float* p, int lane) { Row r; const f32x4* q = (const f32x4*)p + lane;
#pragma unroll
    for (int j = 0; j < 4; ++j) r.v[j] = q[64 * j];
    return r; }
__device__ __forceinline__ float row_rstd(const Row& r) { float s = 0.f;
#pragma unroll
    for (int j = 0; j < 4; ++j) s += (r.v[j].x * r.v[j].x + r.v[j].y * r.v[j].y) + (r.v[j].z * r.v[j].z + r.v[j].w * r.v[j].w);
    return 1.0f / sqrtf(wave_sum(s) * (1.0f / D) + EPS); }
__device__ __forceinline__ void row_store_bf16(bf16* orow, const Row& r, float sc, const Row& g, int lane) {
    unsigned long long* o8 = (unsigned long long*)orow + lane;
#pragma unroll
    for (int j = 0; j < 4; ++j) { const f32x4 y = r.v[j] * sc * g.v[j]; o8[64 * j] = (unsigned long long)pk2(y.x, y.y) | ((unsigned long long)pk2(y.z, y.w) << 32); }
}
__device__ __forceinline__ void row_store_f32(float* orow, const Row& r, int lane) { f32x4* q = (f32x4*)orow + lane;
#pragma unroll
    for (int j = 0; j < 4; ++j) q[64 * j] = r.v[j]; }
__device__ __forceinline__ void rows_norm_bf16(const float* x, const float* g, bf16* xn, int nrows, int gw, int ngw, int lane) {
    const Row G = row_load(g, lane);
    for (int m = gw; m < nrows; m += ngw) { const Row r = row_load(x + (size_t)m * D, lane); row_store_bf16(xn + (size_t)m * D, r, row_rstd(r), G, lane); }
}
template <bool FINAL>
__device__ __forceinline__ void rows_resid(const float* hin, const float* f, float w, const float* g1, const float* g2, float* hout, bf16* xn, int gw, int ngw, int lane) {
    const Row G1 = row_load(g1, lane), G2 = row_load(g2, lane);
    for (int m = gw; m < T; m += ngw) {
        const Row fr = row_load(f + (size_t)m * D, lane); Row h = row_load(hin + (size_t)m * D, lane);
        const float sc = row_rstd(fr) * w;
#pragma unroll
        for (int j = 0; j < 4; ++j) h.v[j] = h.v[j] + fr.v[j] * sc * G1.v[j];
        const float s2 = row_rstd(h);
        if (FINAL) { Row o;
#pragma unroll
            for (int j = 0; j < 4; ++j) o.v[j] = h.v[j] * s2 * G2.v[j];
            row_store_f32(hout + (size_t)m * D, o, lane);
        } else { row_store_f32(hout + (size_t)m * D, h, lane); row_store_bf16(xn + (size_t)m * D, h, s2, G2, lane); }
    }
}

#define XB_TMO      128
#define XB_XCNT(j)  (256  + 64 * (j))
#define XB_XSUB(j)  (1280 + 64 * (j))
#define XB_XGEN(j)  (2304 + 64 * (j))
#define XB_TOP      3328
#define XB_TOPGEN   3392
#define XCD_BAR_WORDS 3456
#define XB_SPIN_CAP (1u << 18)

__device__ __forceinline__ unsigned xb_ld(unsigned* p)              { return __hip_atomic_load(p, __ATOMIC_RELAXED, __HIP_MEMORY_SCOPE_AGENT); }
__device__ __forceinline__ unsigned xb_add(unsigned* p, unsigned v) { return __hip_atomic_fetch_add(p, v, __ATOMIC_RELAXED, __HIP_MEMORY_SCOPE_AGENT); }
__device__ __forceinline__ unsigned xb_xcc_id() { return (unsigned)__builtin_amdgcn_s_getreg((3 << 11) | 20) & 0xFu; }
#define XB_SPIN(cond, bar) do { unsigned _sp = 0; while (cond) { __builtin_amdgcn_s_sleep(1); \
    if ((++_sp & 255u) == 0u) { if (xb_ld(&(bar)[XB_TMO])) break; if (_sp > XB_SPIN_CAP) { atomicAdd(&(bar)[XB_TMO], 1u); break; } } } } while (0)

struct XcdBarrier {
    unsigned* bar; unsigned x;
    volatile LAS unsigned* st;
};

__device__ __forceinline__ XcdBarrier xcd_barrier_post(unsigned* bar, volatile LAS unsigned* st) {
    XcdBarrier b; b.bar = bar; b.x = xb_xcc_id(); b.st = st;
    if (threadIdx.x == 0) (void)xb_add(&bar[XB_XCNT(b.x)], 1u);
    return b;
}
__device__ __forceinline__ void xcd_barrier_complete(unsigned* bar, unsigned x, unsigned& nloc, unsigned& nx) {
    const unsigned G = gridDim.x * gridDim.y * gridDim.z;
    unsigned sum, cnt, mine, sp = 0u;
    for (;;) {
        sum = 0u; cnt = 0u; mine = 0u;
#pragma unroll
        for (unsigned j = 0; j < 16; ++j) { const unsigned c = xb_ld(&bar[XB_XCNT(j)]); sum += c; cnt += (c > 0u) ? 1u : 0u; mine = (j == x) ? c : mine; }
        if (sum == G) break;
        __builtin_amdgcn_s_sleep(1);
        if ((++sp & 255u) == 0u) { if (xb_ld(&bar[XB_TMO])) break; if (sp > XB_SPIN_CAP) { atomicAdd(&bar[XB_TMO], 1u); break; } }
    }
    nloc = mine > 0u ? mine : 1u; nx = cnt > 0u ? cnt : 1u;
}

__device__ __forceinline__ void xcd_barrier(const XcdBarrier& b) {
    asm volatile("s_waitcnt vmcnt(0)" ::: "memory");
    __syncthreads();
    if (threadIdx.x == 0) {
        unsigned* bar = b.bar;
        __builtin_amdgcn_s_waitcnt(0);
        unsigned nloc = b.st[0], nx = b.st[1];
        if (nloc == 0u) { xcd_barrier_complete(bar, b.x, nloc, nx); b.st[0] = nloc; b.st[1] = nx; }
        const unsigned old = xb_add(&bar[XB_XSUB(b.x)], 1u);
        const unsigned gen = old / nloc;
        if (old + 1u == (gen + 1u) * nloc) {
            __builtin_amdgcn_fence(__ATOMIC_RELEASE, "agent");
            asm volatile("s_waitcnt vmcnt(0)" ::: "memory");
            const unsigned og = xb_add(&bar[XB_TOP], 1u);
            const unsigned tg = og / nx;
            if (og + 1u == (tg + 1u) * nx) xb_add(&bar[XB_TOPGEN], 1u);
            else XB_SPIN(xb_ld(&bar[XB_TOPGEN]) == tg, bar);
            __builtin_amdgcn_fence(__ATOMIC_ACQUIRE, "agent");
            xb_add(&bar[XB_XGEN(b.x)], 1u);
            asm volatile("s_waitcnt vmcnt(0)" ::: "memory");
        } else {
            XB_SPIN(xb_ld(&bar[XB_XGEN(b.x)]) == gen, bar);
            __builtin_amdgcn_fence(__ATOMIC_ACQUIRE, "agent");
            asm volatile("s_waitcnt vmcnt(0)" ::: "memory");
        }
    }
    __syncthreads();
}
constexpr float SB_THR = -152.0f;
__device__ __forceinline__ void sb_unit(const bf16* Q, const bf16* Kk, const bf16* VT, const float* gb, bf16* merged, LAS float* red, int unit, int wave, int lane) {
    const int b = unit >> 6, q0 = (unit & 63) * 64, h = wave, j = lane & 31, hi = lane >> 5;
    const size_t tb = (size_t)b * SEQ;
    const bf16* Qp = Q + tb * 512 + h * 64;
    const bf16* Kp = Kk + tb * 512 + h * 64;
    const bf16* Vp = VT + (size_t)(h * 64) * T + tb;
    const float CSC = 0.125f * LOG2E;
    bf16x8 qf[2][4];
#pragma unroll
    for (int qg = 0; qg < 2; ++qg)
#pragma unroll
        for (int kk = 0; kk < 4; ++kk) qf[qg][kk] = *(const bf16x8*)(Qp + (size_t)(q0 + 32 * qg + j) * 512 + 16 * kk + 8 * hi);
    f32x16 o[2][2];
#pragma unroll
    for (int a = 0; a < 2; ++a)
#pragma unroll
        for (int c = 0; c < 2; ++c)
#pragma unroll
            for (int r = 0; r < 16; ++r) o[a][c][r] = 0.f;
    float carry[2] = {0.f, 0.f}; bool done[2] = {false, false};
    for (int kt = (q0 >> 5) + 1; kt >= 0; --kt) {
        const int k0 = kt * 32;
        bf16x8 kf[4], vf[2][2];
#pragma unroll
        for (int kk = 0; kk < 4; ++kk) kf[kk] = *(const bf16x8*)(Kp + (size_t)(k0 + j) * 512 + 16 * kk + 8 * hi);
#pragma unroll
        for (int dt = 0; dt < 2; ++dt)
#pragma unroll
            for (int ks = 0; ks < 2; ++ks) { const bf16* vp = Vp + (size_t)(dt * 32 + j) * T + k0 + 16 * ks + 4 * hi;
                const s16x4 lo = *(const s16x4*)vp, h4 = *(const s16x4*)(vp + 8);
                vf[dt][ks] = (bf16x8){lo[0], lo[1], lo[2], lo[3], h4[0], h4[1], h4[2], h4[3]}; }
#pragma unroll
        for (int qg = 0; qg < 2; ++qg) {
            const int qbase = q0 + 32 * qg;
            if (done[qg] || k0 > qbase + 31) continue;
            f32x16 z;
#pragma unroll
            for (int r = 0; r < 16; ++r) z[r] = 0.f;
#pragma unroll
            for (int kk = 0; kk < 4; ++kk) z = MFMA32(kf[kk], qf[qg][kk], z);
            const bool diag = (k0 + 31 >= qbase);
            const int tq = qbase + j;
            float L[16], lb[16];
#pragma unroll
            for (int r = 0; r < 16; ++r) {
                const float zz = z[r] * CSC;
                const float e = __builtin_amdgcn_exp2f(-__builtin_fabsf(zz));
                const float sp = __builtin_fmaxf(zz, 0.f) + __builtin_amdgcn_logf(1.0f + e);
                const bool valid = !diag || (k0 + crow(r, hi) < tq);
                L[r] = valid ? -sp : 0.f;
                lb[r] = valid ? (zz - sp) : -1.0e30f;
            }
            float G[4], Gp[4];
#pragma unroll
            for (int g = 0; g < 4; ++g) { G[g] = (L[4 * g] + L[4 * g + 1]) + (L[4 * g + 2] + L[4 * g + 3]); Gp[g] = __shfl_xor(G[g], 32); }
            float run = carry[qg];
            float a[16];
#pragma unroll
            for (int g = 3; g >= 0; --g) {
                const float s3 = run + (hi == 0 ? Gp[g] : 0.f);
                const float s2 = s3 + L[4 * g + 3], s1 = s2 + L[4 * g + 2], s0 = s1 + L[4 * g + 1];
                a[4 * g + 3] = __builtin_amdgcn_exp2f(lb[4 * g + 3] + s3);
                a[4 * g + 2] = __builtin_amdgcn_exp2f(lb[4 * g + 2] + s2);
                a[4 * g + 1] = __builtin_amdgcn_exp2f(lb[4 * g + 1] + s1);
                a[4 * g + 0] = __builtin_amdgcn_exp2f(lb[4 * g + 0] + s0);
                run += G[g] + Gp[g];
            }
            carry[qg] = run;
#pragma unroll
            for (int ks = 0; ks < 2; ++ks) {
                v4u w; w.x = cvtpk(a[8 * ks], a[8 * ks + 1]); w.y = cvtpk(a[8 * ks + 2], a[8 * ks + 3]); w.z = cvtpk(a[8 * ks + 4], a[8 * ks + 5]); w.w = cvtpk(a[8 * ks + 6], a[8 * ks + 7]);
                const bf16x8 pf = __builtin_bit_cast(bf16x8, w);
#pragma unroll
                for (int dt = 0; dt < 2; ++dt) o[qg][dt] = MFMA32(vf[dt][ks], pf, o[qg][dt]);
            }
            if (!diag && __all(run < SB_THR)) done[qg] = true;
        }
        if (done[0] && done[1]) break;
    }
#pragma unroll
    for (int qg = 0; qg < 2; ++qg) { float s = 0.f;
#pragma unroll
        for (int dt = 0; dt < 2; ++dt)
#pragma unroll
            for (int r = 0; r < 16; ++r) s += o[qg][dt][r] * o[qg][dt][r];
        s += __shfl_xor(s, 32);
        if (hi == 0) red[h * 64 + 32 * qg + j] = s; }
    __syncthreads();
#pragma unroll
    for (int qg = 0; qg < 2; ++qg) { float tot = 0.f;
#pragma unroll
        for (int hh = 0; hh < 8; ++hh) tot += red[hh * 64 + 32 * qg + j];
        const float rb = 1.0f / sqrtf(tot * (1.0f / 512.0f) + EPS);
        bf16* orow = merged + (tb + q0 + 32 * qg + j) * 1024 + 512 + h * 64;
#pragma unroll
        for (int dt = 0; dt < 2; ++dt)
#pragma unroll
            for (int g = 0; g < 4; ++g) { const int d0 = dt * 32 + 8 * g + 4 * hi; const f32x4 gv = *(const f32x4*)(gb + h * 64 + d0);
                v2u w; w.x = cvtpk(o[qg][dt][4 * g] * rb * gv.x, o[qg][dt][4 * g + 1] * rb * gv.y); w.y = cvtpk(o[qg][dt][4 * g + 2] * rb * gv.z, o[qg][dt][4 * g + 3] * rb * gv.w);
                *(v2u*)(orow + d0) = w; } }
    __syncthreads();
}

template <int TH>
__device__ __forceinline__ void sgu_unit(const bf16* __restrict__ U, const bf16* __restrict__ VG, const bf16* __restrict__ VGT, const float* __restrict__ ng, const float* __restrict__ nb,
                                         const float* __restrict__ Ws, const float* __restrict__ bs, const float* __restrict__ og, bf16* merged,
                                         LAS unsigned char* lds, int bc, int tid, int wave, int lane) {
    constexpr int NKS = 4 * (TH + 1), SLEN = 64 * (TH + 1);
    const int b = bc >> 5, c = bc & 31;
    const size_t tok0 = (size_t)b * SEQ + (size_t)c * 128;
    LAS f32x2_t* st = (LAS f32x2_t*)lds;
    LAS float* red = (LAS float*)(lds + 4096);
    LAS v2u* stash = (LAS v2u*)(lds + 8192);
    __syncthreads();
    {
        const int s = tid >> 2, qd = tid & 3;
        if (s < SLEN) {
            v4u raw[4][4];
#pragma unroll
            for (int g = 0; g < 4; ++g) { const v4u* p = (const v4u*)(VG + (tok0 + s) * 512 + g * 128 + 32 * qd);
#pragma unroll
                for (int i = 0; i < 4; ++i) raw[g][i] = p[i]; }
#pragma unroll
            for (int g = 0; g < 4; ++g) {
                float x[32];
#pragma unroll
                for (int i = 0; i < 4; ++i) { const v4u w = raw[g][i]; x[8 * i] = bflo(w.x); x[8 * i + 1] = bfhi(w.x); x[8 * i + 2] = bflo(w.y); x[8 * i + 3] = bfhi(w.y);
                    x[8 * i + 4] = bflo(w.z); x[8 * i + 5] = bfhi(w.z); x[8 * i + 6] = bflo(w.w); x[8 * i + 7] = bfhi(w.w); }
                float sm = 0.f;
#pragma unroll
                for (int i = 0; i < 32; ++i) sm += x[i];
                sm += __shfl_xor(sm, 1); sm += __shfl_xor(sm, 2);
                const float mu = sm * (1.0f / 128.0f); float vs = 0.f;
#pragma unroll
                for (int i = 0; i < 32; ++i) { const float dlt = x[i] - mu; vs += dlt * dlt; }
                vs += __shfl_xor(vs, 1); vs += __shfl_xor(vs, 2);
                const float rstd = 1.0f / sqrtf(vs * (1.0f / 128.0f) + EPS);
                if (qd == 0) st[g * 128 + s] = (f32x2_t){mu, rstd};
            }
        }
    }
    __syncthreads();
    const int tl = 32 * (wave & 1) + (lane & 31), dq = wave >> 1, j = lane & 31, hi = lane >> 5;
    const int t = 64 * TH + tl;
    float ssq = 0.f;
#pragma unroll 1
    for (int g = 0; g < 4; ++g) {
        const float* wrow = Ws + (size_t)g * 128 * 128 + (size_t)t * 128 + 8 * hi;
        const bf16* vgt = VGT + (size_t)(g * 128 + 32 * dq + j) * T + tok0 + 8 * hi;
        f32x4 wv[NKS][2]; bf16x8 af[NKS];
#pragma unroll
        for (int ks = 0; ks < NKS; ++ks) { wv[ks][0] = *(const f32x4*)(wrow + 16 * ks); wv[ks][1] = *(const f32x4*)(wrow + 16 * ks + 4); af[ks] = *(const bf16x8*)(vgt + 16 * ks); }
        const float bias = bs[g * 128 + t];
        const bf16* urow = U + (tok0 + t) * 512 + g * 128 + 32 * dq;
        v2u uw[4]; f32x4 gv[4], bv[4];
#pragma unroll
        for (int q = 0; q < 4; ++q) { const int d0 = 8 * q + 4 * hi; uw[q] = *(const v2u*)(urow + d0); gv[q] = *(const f32x4*)(ng + g * 128 + 32 * dq + d0); bv[q] = *(const f32x4*)(nb + g * 128 + 32 * dq + d0); }
        f32x16 acc;
#pragma unroll
        for (int r = 0; r < 16; ++r) acc[r] = 0.f;
        float c1 = 0.f, c2 = 0.f;
#pragma unroll
        for (int ks = 0; ks < NKS; ++ks) {
            const int s0 = 16 * ks + 8 * hi;
            const float wf[8] = {wv[ks][0].x, wv[ks][0].y, wv[ks][0].z, wv[ks][0].w, wv[ks][1].x, wv[ks][1].y, wv[ks][1].z, wv[ks][1].w};
            float wp[8];
#pragma unroll
            for (int e = 0; e < 8; ++e) { const f32x2_t ms = st[g * 128 + s0 + e]; const float w = (s0 + e <= t) ? wf[e] : 0.f;
                const float wr = __builtin_bit_cast(float, f2bf(w * ms.y) << 16);
                wp[e] = wr; c1 += wr * ms.x; c2 += w; }
            v4u bw; bw.x = cvtpk(wp[0], wp[1]); bw.y = cvtpk(wp[2], wp[3]); bw.z = cvtpk(wp[4], wp[5]); bw.w = cvtpk(wp[6], wp[7]);
            acc = MFMA32(af[ks], __builtin_bit_cast(bf16x8, bw), acc);
        }
        c1 += __shfl_xor(c1, 32); c2 += __shfl_xor(c2, 32);
#pragma unroll
        for (int q = 0; q < 4; ++q) {
            const float o0 = bflo(uw[q].x) * (gv[q].x * (acc[4 * q] - c1) + bv[q].x * c2 + bias), o1 = bfhi(uw[q].x) * (gv[q].y * (acc[4 * q + 1] - c1) + bv[q].y * c2 + bias);
            const float o2 = bflo(uw[q].y) * (gv[q].z * (acc[4 * q + 2] - c1) + bv[q].z * c2 + bias), o3 = bfhi(uw[q].y) * (gv[q].w * (acc[4 * q + 3] - c1) + bv[q].w * c2 + bias);
            ssq += (o0 * o0 + o1 * o1) + (o2 * o2 + o3 * o3);
            v2u w; w.x = cvtpk(o0, o1); w.y = cvtpk(o2, o3);
            stash[(g * 4 + q) * 512 + tid] = w; }
    }
    ssq += __shfl_xor(ssq, 32);
    if (hi == 0) red[dq * 64 + tl] = ssq;
    __syncthreads();
    const float rn = 1.0f / sqrtf(((red[tl] + red[64 + tl]) + (red[128 + tl] + red[192 + tl])) * (1.0f / 512.0f) + EPS);
    {   v2u r[4][4];
#pragma unroll
        for (int g = 0; g < 4; ++g)
#pragma unroll
            for (int q = 0; q < 4; ++q) r[g][q] = stash[(g * 4 + q) * 512 + tid];
#pragma unroll
        for (int g = 0; g < 4; ++g)
#pragma unroll
            for (int q = 0; q < 4; ++q) { const int d0 = 8 * q + 4 * hi; const f32x4 gq = *(const f32x4*)(og + g * 128 + 32 * dq + d0);
                v2u w; w.x = cvtpk(bflo(r[g][q].x) * rn * gq.x, bfhi(r[g][q].x) * rn * gq.y); w.y = cvtpk(bflo(r[g][q].y) * rn * gq.z, bfhi(r[g][q].y) * rn * gq.w);
                *(v2u*)(merged + (tok0 + t) * 1024 + g * 128 + 32 * dq + d0) = w; } }
}

__device__ __forceinline__ void xa_unit(const bf16* Qx, const bf16* Km, const bf16* VmT, bf16* Oc, LAS unsigned char* lds, int unit, int tid, int wave, int lane) {
    const int b = unit >> 7, h = (unit >> 5) & 3, qt = unit & 31, fr = lane & 15, fq = lane >> 4;
    const size_t tok = (size_t)b * SEQ + (size_t)qt * 128 + wave * 16 + fr;
    LAS unsigned char* Kl = lds;
    LAS unsigned char* Vl = lds + 33792;
    bf16x8 qf[8];
#pragma unroll
    for (int kk = 0; kk < 8; ++kk) qf[kk] = *(const bf16x8*)(Qx + tok * 1024 + h * 256 + 32 * kk + 8 * fq);
    f32x4 s[16];
#pragma unroll
    for (int i = 0; i < 16; ++i) s[i] = (f32x4){0.f, 0.f, 0.f, 0.f};
#pragma unroll
    for (int c = 0; c < 4; ++c) {
        __syncthreads();
#pragma unroll
        for (int i = 0; i < 4; ++i) { const int idx = tid + 512 * i, row = idx >> 5, piece = idx & 31;
            const v4u val = *(const v4u*)(Km + (size_t)(b * MEMLEN + c * 64 + row) * 1024 + h * 256 + piece * 8);
            *(LAS v4u*)(Kl + row * 528 + piece * 16) = val; }
        __syncthreads();
#pragma unroll
        for (int mt = 0; mt < 4; ++mt)
#pragma unroll
            for (int kk = 0; kk < 8; ++kk) { const bf16x8 a = *(const LAS bf16x8*)(Kl + (mt * 16 + fr) * 528 + (32 * kk + 8 * fq) * 2);
                s[c * 4 + mt] = MFMA16(a, qf[kk], s[c * 4 + mt]); }
    }
    float mx = -3.0e38f;
#pragma unroll
    for (int i = 0; i < 16; ++i) mx = __builtin_fmaxf(mx, __builtin_fmaxf(__builtin_fmaxf(s[i].x, s[i].y), __builtin_fmaxf(s[i].z, s[i].w)));
    mx = __builtin_fmaxf(mx, __shfl_xor(mx, 16)); mx = __builtin_fmaxf(mx, __shfl_xor(mx, 32));
    const float c2 = 0.0625f * LOG2E; float sum = 0.f;
#pragma unroll
    for (int i = 0; i < 16; ++i) { f32x4 p; p.x = __builtin_amdgcn_exp2f((s[i].x - mx) * c2); p.y = __builtin_amdgcn_exp2f((s[i].y - mx) * c2);
        p.z = __builtin_amdgcn_exp2f((s[i].z - mx) * c2); p.w = __builtin_amdgcn_exp2f((s[i].w - mx) * c2); s[i] = p; sum += (p.x + p.y) + (p.z + p.w); }
    sum += __shfl_xor(sum, 16); sum += __shfl_xor(sum, 32);
    const float inv = 1.0f / sum;
    bf16x8 pf[8];
#pragma unroll
    for (int sp = 0; sp < 8; ++sp) { v4u w; w.x = cvtpk(s[2 * sp].x, s[2 * sp].y); w.y = cvtpk(s[2 * sp].z, s[2 * sp].w); w.z = cvtpk(s[2 * sp + 1].x, s[2 * sp + 1].y); w.w = cvtpk(s[2 * sp + 1].z, s[2 * sp + 1].w);
        pf[sp] = __builtin_bit_cast(bf16x8, w); }
    f32x4 o[16];
#pragma unroll
    for (int i = 0; i < 16; ++i) o[i] = (f32x4){0.f, 0.f, 0.f, 0.f};
#pragma unroll
    for (int c = 0; c < 4; ++c) {
        __syncthreads();
#pragma unroll
        for (int i = 0; i < 4; ++i) { const int idx = tid + 512 * i, row = idx >> 3, piece = idx & 7;
            const v4u val = *(const v4u*)(VmT + (size_t)(h * 256 + row) * TM + b * MEMLEN + c * 64 + piece * 8);
            *(LAS v4u*)(Vl + row * 144 + piece * 16) = val; }
        __syncthreads();
#pragma unroll
        for (int s2 = 0; s2 < 2; ++s2)
#pragma unroll
            for (int dt = 0; dt < 16; ++dt) { const LAS unsigned char* vp = Vl + (dt * 16 + fr) * 144 + (32 * s2 + 4 * fq) * 2;
                const s16x4 lo = *(const LAS s16x4*)vp, h4 = *(const LAS s16x4*)(vp + 32);
                const bf16x8 a = (bf16x8){lo[0], lo[1], lo[2], lo[3], h4[0], h4[1], h4[2], h4[3]};
                o[dt] = MFMA16(a, pf[2 * c + s2], o[dt]); }
    }
    bf16* orow = Oc + tok * 1024 + h * 256;
#pragma unroll
    for (int dt = 0; dt < 16; ++dt) { v2u w; w.x = cvtpk(o[dt].x * inv, o[dt].y * inv); w.y = cvtpk(o[dt].z * inv, o[dt].w * inv); *(v2u*)(orow + dt * 16 + 4 * fq) = w; }
}
struct Args { const float* in[N_IN]; float* out; unsigned char* ws; int ph_lo, ph_hi; };
static_assert(sizeof(Args) == N_IN * 8 + 8 + 8 + 8, "Args has no padding bytes");
constexpr int N_PHASES = 15;

__global__ void __launch_bounds__(NWAVES * 64, 2) fwd_megakernel(Args args) {
    extern __shared__ __attribute__((aligned(16))) unsigned char lds_raw[];
    LAS unsigned char* lds = (LAS unsigned char*)lds_raw;
    const int tid = threadIdx.x, lane = tid & 63, wave = __builtin_amdgcn_readfirstlane(tid >> 6);
    const int G = gridDim.x, bx = blockIdx.x;
    const int gw = bx * NWAVES + wave, ngw = G * NWAVES;
    unsigned char* ws = args.ws;
    bf16* Wgu1 = (bf16*)(ws + WS_WGU1); bf16* Wd1 = (bf16*)(ws + WS_WD1); bf16* Win = (bf16*)(ws + WS_WIN); bf16* Wout = (bf16*)(ws + WS_WOUT); bf16* Wq = (bf16*)(ws + WS_WQ);
    bf16* Wkv = (bf16*)(ws + WS_WKV); bf16* Wo = (bf16*)(ws + WS_WO); bf16* Wgu2 = (bf16*)(ws + WS_WGU2); bf16* Wd2 = (bf16*)(ws + WS_WD2);
    bf16* MEMN = (bf16*)(ws + WS_MEMN); bf16* KMEM = (bf16*)(ws + WS_KMEM); bf16* VMT = (bf16*)(ws + WS_VMT);
    bf16* XN = (bf16*)(ws + WS_XN); bf16* HB = (bf16*)(ws + WS_HB);
    bf16* UB = (bf16*)(ws + WS_U); bf16* VGB = (bf16*)(ws + WS_VG); bf16* QB = (bf16*)(ws + WS_Q); bf16* KB = (bf16*)(ws + WS_KK); bf16* VTB = (bf16*)(ws + WS_VT); bf16* VGT = (bf16*)(ws + WS_VGT);
    bf16* QX = (bf16*)(ws + WS_QX); bf16* OC = (bf16*)(ws + WS_OC);
    float* FB = (float*)(ws + WS_F); float* HA = args.out;
    const int lo = args.ph_lo, hi = args.ph_hi;
    volatile LAS unsigned* MISC = (volatile LAS unsigned*)(lds + RING_BYTES + 320);
    if (tid < 64) MISC[tid] = 0u;
    __syncthreads();
    XcdBarrier bar; bar.bar = (unsigned*)(ws + WS_CTL); bar.x = 0; bar.st = nullptr;
    if (hi - lo > 1) {
        cg::this_grid().sync();
        bar = xcd_barrier_post((unsigned*)(ws + WS_CTL), MISC + 8);
    }
#define IN(k) (lo <= (k) && (k) < hi)
#define SEAM(k) do { if (lo <= (k) && (k) + 1 < hi) xcd_barrier(bar); } while (0)
#ifndef PROBE_PHASE
#define PROBE_PHASE (-1)
#endif
#define REP(k) for (int rep_ = 0; rep_ < ((k) == PROBE_PHASE ? 2 : 1); ++rep_)
#define GEMM(EPI, g, S, E) pg8::gemm_phase<EPI, pg8::StaticOrder, PG8_ALIGN, PG8_SP2>(lds, g, S, E)

    if (IN(0)) REP(0) {
        LAS float* scr = (LAS float*)(lds + wave * 16384);
        constexpr int I_GU = (D / 64) * (FF / 32), I_DN = (FF / 64) * (D / 32), I_IN = (D / 64) * (2560 / 32), I_SQ = (D / 64) * (D / 32), I_KV = (D / 64) * (2048 / 32);
        constexpr int NITEMS = 4 * I_GU + 2 * I_DN + I_IN + 3 * I_SQ + I_KV;
        for (int it = gw; it < NITEMS; it += ngw) {
            int r = it;
            if (r < I_GU) { transpose_mat(args.in[I_F1WG], D, FF, Wgu1, 1, r, scr, lane); continue; } r -= I_GU;
            if (r < I_GU) { transpose_mat(args.in[I_F1WU], D, FF, Wgu1, 2, r, scr, lane); continue; } r -= I_GU;
            if (r < I_DN) { transpose_mat(args.in[I_F1WD], FF, D, Wd1, 0, r, scr, lane); continue; } r -= I_DN;
            if (r < I_IN) { transpose_mat(args.in[I_WIN], D, 2560, Win, 0, r, scr, lane); continue; } r -= I_IN;
            if (r < I_SQ) { transpose_mat(args.in[I_WOUT], D, D, Wout, 0, r, scr, lane); continue; } r -= I_SQ;
            if (r < I_SQ) { transpose_mat(args.in[I_XAWQ], D, D, Wq, 0, r, scr, lane); continue; } r -= I_SQ;
            if (r < I_KV) { transpose_mat(args.in[I_XAWKV], D, 2048, Wkv, 0, r, scr, lane); continue; } r -= I_KV;
            if (r < I_SQ) { transpose_mat(args.in[I_XAWO], D, D, Wo, 0, r, scr, lane); continue; } r -= I_SQ;
            if (r < I_GU) { transpose_mat(args.in[I_F2WG], D, FF, Wgu2, 1, r, scr, lane); continue; } r -= I_GU;
            if (r < I_GU) { transpose_mat(args.in[I_F2WU], D, FF, Wgu2, 2, r, scr, lane); continue; } r -= I_GU;
            transpose_mat(args.in[I_F2WD], FF, D, Wd2, 0, r, scr, lane);
        }
        rows_norm_bf16(args.in[I_X], args.in[I_F1PRE], XN, T, gw, ngw, lane);
        rows_norm_bf16(args.in[I_MEM], args.in[I_MEMG], MEMN, TM, gw, ngw, lane);
    }
    SEAM(0);
    if (IN(1)) REP(1) {
        { pg8::Gemm g{XN, Wgu1, T, 2 * FF, D}; pg8::StaticOrder S; S.init(T, 2 * FF, G, bx); pg8::EpiSwiGLU E{HB, FF}; GEMM(pg8::EpiSwiGLU, g, S, E); }
        const int sb = (G == 256) ? bx - 128 : bx;
        { pg8::Gemm g{MEMN, Wkv, TM, 1024, D}; pg8::StaticOrder S; S.init(TM, 1024, G, (sb >= 0 && sb < 16) ? sb : (1 << 20)); pg8::EpiBf16P E{KMEM, 1024, 0, 0, 0}; GEMM(pg8::EpiBf16P, g, S, E); }
        { pg8::Gemm g{Wkv + (size_t)1024 * D, MEMN, 1024, TM, D}; pg8::StaticOrder S; S.init(1024, TM, G, (sb >= 16 && sb < 32) ? sb - 16 : (1 << 20)); pg8::EpiBf16P E{VMT, TM, 0, 0, 0}; GEMM(pg8::EpiBf16P, g, S, E); }
    }
    SEAM(1);
    if (IN(2)) REP(2) { pg8::Gemm g{HB, Wd1, T, D, FF}; pg8::StaticOrder S; S.init(T, D, G, bx); pg8::EpiF32 E{FB, D}; GEMM(pg8::EpiF32, g, S, E); }
    SEAM(2);
    if (IN(3)) REP(3) rows_resid<false>(args.in[I_X], FB, 0.5f, args.in[I_F1POST], args.in[I_MIXPRE], HA, XN, gw, ngw, lane);
    SEAM(3);
    if (IN(4)) REP(4) {
        { pg8::Gemm g{XN, Win, T, 2048, D}; pg8::StaticOrder S; S.init(T, 2048, G, bx); pg8::EpiBf16P E{UB, 512, 512, (size_t)(WS_VG - WS_U) / 2, 2}; GEMM(pg8::EpiBf16P, g, S, E); }
        { pg8::Gemm g{Win + (size_t)2048 * D, XN, 512, T, D}; pg8::StaticOrder S; S.init(512, T, G, bx); pg8::EpiBf16P E{VTB, T, 0, 0, 0}; GEMM(pg8::EpiBf16P, g, S, E); }
        { pg8::Gemm g{Win + (size_t)512 * D, XN, 512, T, D}; pg8::StaticOrder S; S.init(512, T, G, (bx + 128) % G); pg8::EpiBf16P E{VGT, T, 0, 0, 1}; GEMM(pg8::EpiBf16P, g, S, E); }
    }
    SEAM(4);
    if (IN(5)) {
        REP(50) for (int u = bx; u < 256; u += G) sb_unit(QB, KB, VTB, args.in[I_SB_OG], XN, (LAS float*)lds, u, wave, lane);
        REP(51) for (int u = bx; u < 256; u += G) {
            if (u < 128) sgu_unit<1>(UB, VGB, VGT, args.in[I_SGU_NG], args.in[I_SGU_NB], args.in[I_SGU_WS], args.in[I_SGU_BS], args.in[I_SGU_OG], XN, lds, u, tid, wave, lane);
            else sgu_unit<0>(UB, VGB, VGT, args.in[I_SGU_NG], args.in[I_SGU_NB], args.in[I_SGU_WS], args.in[I_SGU_BS], args.in[I_SGU_OG], XN, lds, u - 128, tid, wave, lane); }
    }
    SEAM(5);
    if (IN(6)) REP(6) { pg8::Gemm g{XN, Wout, T, D, D}; pg8::StaticOrder S; S.init(T, D, G, bx); pg8::EpiF32 E{FB, D}; GEMM(pg8::EpiF32, g, S, E); }
    SEAM(6);
    if (IN(7)) rows_resid<false>(HA, FB, 1.0f, args.in[I_MIXPOST], args.in[I_XAPRE], HA, XN, gw, ngw, lane);
    SEAM(7);
    if (IN(8)) REP(8) { pg8::Gemm g{XN, Wq, T, D, D}; pg8::StaticOrder S; S.init(T, D, G, bx); pg8::EpiBf16P E{QX, D, 0, 0, 0}; GEMM(pg8::EpiBf16P, g, S, E); }
    SEAM(8);
    if (IN(9)) REP(9) { for (int u = bx; u < 512; u += G) xa_unit(QX, KMEM, VMT, OC, lds, u, tid, wave, lane); }
    SEAM(9);
    if (IN(10)) REP(10) { pg8::Gemm g{OC, Wo, T, D, D}; pg8::StaticOrder S; S.init(T, D, G, bx); pg8::EpiF32 E{FB, D}; GEMM(pg8::EpiF32, g, S, E); }
    SEAM(10);
    if (IN(11)) rows_resid<false>(HA, FB, 1.0f, args.in[I_XAPOST], args.in[I_F2PRE], HA, XN, gw, ngw, lane);
    SEAM(11);
    if (IN(12)) { pg8::Gemm g{XN, Wgu2, T, 2 * FF, D}; pg8::StaticOrder S; S.init(T, 2 * FF, G, bx); pg8::EpiSwiGLU E{HB, FF}; GEMM(pg8::EpiSwiGLU, g, S, E); }
    SEAM(12);
    if (IN(13)) { pg8::Gemm g{HB, Wd2, T, D, FF}; pg8::StaticOrder S; S.init(T, D, G, bx); pg8::EpiF32 E{FB, D}; GEMM(pg8::EpiF32, g, S, E); }
    SEAM(13);
    if (IN(14)) rows_resid<true>(HA, FB, 0.5f, args.in[I_F2POST], args.in[I_FINAL], HA, nullptr, gw, ngw, lane);
#undef IN
#undef SEAM
#undef GEMM
}

extern "C" void kernel_launch(void* const* d_in, const int* in_sizes, int n_in, void* d_out, int out_size, void* d_ws, size_t ws_size, hipStream_t stream) {
    static int grid = 0;
    if (grid == 0) {
        if (n_in != N_IN || out_size != T * D || ws_size < WS_END) { fprintf(stderr, "kernel_launch: unexpected problem (n_in %d out %d ws %zu); nothing launched\n", n_in, out_size, ws_size); grid = -1; return; }
        int dev = 0, cus = 0, per_cu = 0;
        hipGetDevice(&dev); hipDeviceGetAttribute(&cus, hipDeviceAttributeMultiprocessorCount, dev);
        if (hipFuncSetAttribute((const void*)fwd_megakernel, hipFuncAttributeMaxDynamicSharedMemorySize, LDS_BYTES) != hipSuccess) { fprintf(stderr, "kernel_launch: hipFuncSetAttribute failed\n"); grid = -1; return; }
        if (hipOccupancyMaxActiveBlocksPerMultiprocessor(&per_cu, (const void*)fwd_megakernel, NWAVES * 64, LDS_BYTES) != hipSuccess || per_cu < 1) { fprintf(stderr, "kernel_launch: occupancy query says %d\n", per_cu); per_cu = 1; }
        (void)hipGetLastError();
        grid = cus * per_cu; if (grid > 256) grid = 256;
        fprintf(stderr, "kernel_launch: grid %d (cus %d, per_cu %d)\n", grid, cus, per_cu);
    }
    if (grid < 0) return;
    if (hipMemsetAsync((char*)d_ws + WS_CTL, 0, CTL_ZERO_BYTES, stream) != hipSuccess) { fprintf(stderr, "kernel_launch: memset failed\n"); return; }
    Args a{};
    for (int i = 0; i < N_IN; ++i) a.in[i] = (const float*)d_in[i];
    a.out = (float*)d_out; a.ws = (unsigned char*)d_ws;
#if MK_PER_PHASE
    for (int p = 0; p < N_PHASES; ++p) { a.ph_lo = p; a.ph_hi = p + 1; hipLaunchKernelGGL(fwd_megakernel, dim3(grid), dim3(NWAVES * 64), LDS_BYTES, stream, a); }
#else
    a.ph_lo = 0; a.ph_hi = N_PHASES;
    void* kargs[] = {&a};
    hipError_t e = hipLaunchCooperativeKernel((const void*)fwd_megakernel, dim3(grid), dim3(NWAVES * 64), kargs, LDS_BYTES, stream);
    if (e != hipSuccess) fprintf(stderr, "kernel_launch: cooperative launch failed: %s (grid %d)\n", hipGetErrorString(e), grid);
#endif
}
```
